# Optimizing an MI355X kernel written in HIP

```python
import jax, jax.numpy as jnp
from jax import lax
import numpy as np

D_MODEL = 1024
BATCH = 32
SEQ = 2048
DEPTH = 2

GRID_W = 64
CTX_LEN = 256
HEAD_DIM = 64
ATTN_W = D_MODEL // 2
CONV_W = D_MODEL // 4
POOL_W = D_MODEL // 4
MIX_W = ATTN_W + CONV_W + POOL_W
ATTN_HEADS = ATTN_W // HEAD_DIM
KV_HEADS = ATTN_HEADS // 4
KV_W = KV_HEADS * HEAD_DIM
IN_W = ATTN_W + 2 * KV_W + 2 * CONV_W + POOL_W
WINDOW = 128
Q_BLOCK = 128
SPAN = Q_BLOCK + 2 * WINDOW
CONV_KERNEL = 31
POOL_WINDOWS = (2, 4, 8, 16)
POOL_GROUP = POOL_W // len(POOL_WINDOWS)
ROPE_BASE = 10000.0
D_FF = -(-8 * D_MODEL // (3 * 256)) * 256
EPS = 1e-6
NEG = -1e30

kernel_name = "hybrid_parallel_groups_dit_block"


def rms_norm(x, g):
    xf = x.astype(jnp.float32)
    y = xf * lax.rsqrt(jnp.mean(xf * xf, axis=-1, keepdims=True) + EPS)
    return (y * g.astype(jnp.float32)).astype(x.dtype)


def axial_rope_tables(n, dtype):
    rows = n // GRID_W
    row = jnp.repeat(jnp.arange(rows), GRID_W).astype(jnp.float32)
    col = jnp.tile(jnp.arange(GRID_W), rows).astype(jnp.float32)
    half = HEAD_DIM // 2
    inv = ROPE_BASE ** (-jnp.arange(0, half, 2, dtype=jnp.float32) / half)
    ar = row[:, None] * inv
    ac = col[:, None] * inv
    ang = jnp.concatenate([ar, ar, ac, ac], axis=-1)
    return jnp.cos(ang).astype(dtype), jnp.sin(ang).astype(dtype)


def apply_rope(x, cos, sin):
    xr = x.reshape(*x.shape[:-1], 2, 2, HEAD_DIM // 4)
    rot = jnp.stack([-xr[..., 1, :], xr[..., 0, :]], axis=-2).reshape(x.shape)
    return x * cos[:, None, :] + rot * sin[:, None, :]


def split_in(u):
    b, n, _ = u.shape
    q, k, v, cu, pu = jnp.split(
        u, [ATTN_W, ATTN_W + KV_W, ATTN_W + 2 * KV_W, ATTN_W + 2 * KV_W + 2 * CONV_W], axis=-1)
    return (q.reshape(b, n, ATTN_HEADS, HEAD_DIM), k.reshape(b, n, KV_HEADS, HEAD_DIM),
            v.reshape(b, n, KV_HEADS, HEAD_DIM), cu, pu)


def window_attention(q, k, v, k_ctx, v_ctx, sink):
    b, n, h, hd = q.shape
    kvh = k.shape[2]
    grp = h // kvh
    n_ctx = k_ctx.shape[1]
    nb = n // Q_BLOCK
    scale = HEAD_DIM ** -0.5
    pad = ((0, 0), (WINDOW, WINDOW), (0, 0), (0, 0))
    k_pad = jnp.pad(k, pad)
    v_pad = jnp.pad(v, pad)
    sink_b = jnp.broadcast_to(sink.astype(jnp.float32).reshape(1, kvh, grp, 1, 1), (b, kvh, grp, Q_BLOCK, 1))

    def one_block(i):
        start = i * Q_BLOCK
        qb = lax.dynamic_slice_in_dim(q, start, Q_BLOCK, axis=1).reshape(b, Q_BLOCK, kvh, grp, hd)
        kb = lax.dynamic_slice_in_dim(k_pad, start, SPAN, axis=1)
        vb = lax.dynamic_slice_in_dim(v_pad, start, SPAN, axis=1)
        qpos = start + jnp.arange(Q_BLOCK)
        kpos = start - WINDOW + jnp.arange(SPAN)
        valid = ((jnp.abs(qpos[:, None] - kpos[None, :]) <= WINDOW)
                 & (kpos >= 0)[None, :] & (kpos < n)[None, :])
        s_loc = jnp.einsum('bqkgd,bjkd->bkgqj', qb, kb).astype(jnp.float32) * scale
        s_loc = jnp.where(valid, s_loc, NEG)
        s_ctx = jnp.einsum('bqkgd,bckd->bkgqc', qb, k_ctx).astype(jnp.float32) * scale
        p = jax.nn.softmax(jnp.concatenate([sink_b, s_ctx, s_loc], axis=-1), axis=-1).astype(v.dtype)
        o = (jnp.einsum('bkgqc,bckd->bqkgd', p[..., 1:1 + n_ctx], v_ctx)
             + jnp.einsum('bkgqj,bjkd->bqkgd', p[..., 1 + n_ctx:], vb))
        return o.reshape(b, Q_BLOCK, h * hd)

    o = lax.map(one_block, jnp.arange(nb))
    return jnp.moveaxis(o, 0, 1).reshape(b, n, h * hd)


def context_attention(qc, kc, vc, sink):
    b, n_ctx, h, hd = qc.shape
    kvh = kc.shape[2]
    grp = h // kvh
    qg = qc.reshape(b, n_ctx, kvh, grp, hd)
    s = jnp.einsum('bqkgd,bckd->bkgqc', qg, kc).astype(jnp.float32) * (HEAD_DIM ** -0.5)
    sink_b = jnp.broadcast_to(sink.astype(jnp.float32).reshape(1, kvh, grp, 1, 1), (b, kvh, grp, n_ctx, 1))
    p = jax.nn.softmax(jnp.concatenate([sink_b, s], axis=-1), axis=-1).astype(vc.dtype)
    o = jnp.einsum('bkgqc,bckd->bqkgd', p[..., 1:], vc)
    return o.reshape(b, n_ctx, h * hd)


def conv_module(u, dw, dw_b, ln_g, ln_b):
    a, g = jnp.split(u, 2, axis=-1)
    h = a * jax.nn.sigmoid(g)
    h = lax.conv_general_dilated(
        h, dw[:, None, :], window_strides=(1,),
        padding=[(CONV_KERNEL // 2, CONV_KERNEL // 2)],
        dimension_numbers=('NWC', 'WIO', 'NWC'), feature_group_count=CONV_W) + dw_b
    hf = h.astype(jnp.float32)
    mu = jnp.mean(hf, axis=-1, keepdims=True)
    var = jnp.mean(jnp.square(hf - mu), axis=-1, keepdims=True)
    hn = (hf - mu) * lax.rsqrt(var + EPS) * ln_g.astype(jnp.float32) + ln_b.astype(jnp.float32)
    return jax.nn.silu(hn).astype(u.dtype)


def pool_mixer(p, w, scale):
    b, n, ch = p.shape
    t = jnp.arange(n)
    pf = p.astype(jnp.float32).reshape(b, n, len(POOL_WINDOWS), POOL_GROUP)
    cs = jnp.pad(jnp.cumsum(pf, axis=1), ((0, 0), (1, 0), (0, 0), (0, 0)))
    outs = []
    for gi, win in enumerate(POOL_WINDOWS):
        lo = jnp.maximum(t - win // 2, 0)
        hi = jnp.minimum(t + win - 1 - win // 2, n - 1)
        cg = cs[:, :, gi]
        mean = (cg[:, hi + 1] - cg[:, lo]) / (hi - lo + 1).astype(jnp.float32)[None, :, None]
        outs.append(mean - pf[:, :, gi])
    y = jnp.stack(outs, axis=2).astype(p.dtype)
    y = jnp.einsum('bsgc,gcd->bsgd', y, w).reshape(b, n, ch)
    return y * scale


def mixer_output(attn, cu, pu, w_out, dw, dw_b, ln_g, ln_b, pw, ps):
    conv = conv_module(cu, dw, dw_b, ln_g, ln_b)
    pool = pool_mixer(pu, pw, ps)
    return jnp.concatenate([attn, conv, pool], axis=-1) @ w_out


def swiglu(h, w_in, w_out):
    g, u = jnp.split(h @ w_in, 2, axis=-1)
    return (jax.nn.silu(g) * u) @ w_out


def setup_inputs(seed: int = 0) -> dict:
    key = jax.random.key(seed)
    ks = jax.random.split(key, 24)
    f32 = jnp.float32
    nrm = lambda k, shape, s: jax.random.normal(k, shape, f32) * s
    return {
        "x": nrm(ks[0], (BATCH, SEQ, D_MODEL), 1.0),
        "c": nrm(ks[1], (BATCH, D_MODEL), 1.0),
        "ctx": nrm(ks[2], (BATCH, CTX_LEN, D_MODEL), 1.0),
        "c_ctx": nrm(ks[3], (D_MODEL,), 1.0),
        "w_mod": nrm(ks[4], (DEPTH, D_MODEL, 6 * D_MODEL), 0.5 * D_MODEL ** -0.5),
        "b_mod": nrm(ks[5], (DEPTH, 6 * D_MODEL), 0.01),
        "norm1_g": 1.0 + nrm(ks[6], (DEPTH, D_MODEL), 0.05),
        "norm2_g": 1.0 + nrm(ks[7], (DEPTH, D_MODEL), 0.05),
        "w_in": nrm(ks[8], (DEPTH, D_MODEL, IN_W), D_MODEL ** -0.5),
        "conv_dw": nrm(ks[9], (DEPTH, CONV_KERNEL, CONV_W), CONV_KERNEL ** -0.5),
        "conv_dw_b": nrm(ks[10], (DEPTH, CONV_W), 0.01),
        "conv_ln_g": 1.0 + nrm(ks[11], (DEPTH, CONV_W), 0.05),
        "conv_ln_b": nrm(ks[12], (DEPTH, CONV_W), 0.01),
        "attn_sink": nrm(ks[13], (DEPTH, ATTN_HEADS), 0.5),
        "pool_w": nrm(ks[14], (DEPTH, len(POOL_WINDOWS), POOL_GROUP, POOL_GROUP), POOL_GROUP ** -0.5),
        "pool_scale": 1.0 + nrm(ks[15], (DEPTH, POOL_W), 0.05),
        "w_out": nrm(ks[16], (DEPTH, MIX_W, D_MODEL), MIX_W ** -0.5),
        "w_ffn_in": nrm(ks[17], (DEPTH, D_MODEL, 2 * D_FF), D_MODEL ** -0.5),
        "w_ffn_out": nrm(ks[18], (DEPTH, D_FF, D_MODEL), D_FF ** -0.5),
        "final_g": 1.0 + nrm(ks[19], (D_MODEL,), 0.05),
    }


def reference(x, c, ctx, c_ctx, w_mod, b_mod, norm1_g, norm2_g, w_in, conv_dw, conv_dw_b,
              conv_ln_g, conv_ln_b, attn_sink, pool_w, pool_scale, w_out, w_ffn_in, w_ffn_out, final_g):
    b, n, _ = x.shape
    n_ctx = ctx.shape[1]
    cos, sin = axial_rope_tables(n, x.dtype)
    cx = ctx
    for l in range(DEPTH):
        last = l == DEPTH - 1
        m = (jax.nn.silu(c) @ w_mod[l] + b_mod[l])[:, None, :]
        sh1, sc1, g1, sh2, sc2, g2 = jnp.split(m, 6, axis=-1)
        mc = jax.nn.silu(c_ctx) @ w_mod[l] + b_mod[l]
        csh1, csc1, cg1, csh2, csc2, cg2 = jnp.split(mc, 6)

        hl = rms_norm(x, norm1_g[l]) * (1.0 + sc1) + sh1
        hc = rms_norm(cx, norm1_g[l]) * (1.0 + csc1) + csh1
        q, k, v, cu, pu = split_in(hl @ w_in[l])
        if last:
            kvc = hc @ w_in[l][:, ATTN_W:ATTN_W + 2 * KV_W]
            kc, vc = [t.reshape(b, n_ctx, KV_HEADS, HEAD_DIM) for t in jnp.split(kvc, 2, axis=-1)]
        else:
            qc, kc, vc, cuc, puc = split_in(hc @ w_in[l])
        q = apply_rope(q, cos, sin)
        k = apply_rope(k, cos, sin)
        attn = window_attention(q, k, v, kc, vc, attn_sink[l])
        x = x + g1 * mixer_output(attn, cu, pu, w_out[l], conv_dw[l], conv_dw_b[l],
                                  conv_ln_g[l], conv_ln_b[l], pool_w[l], pool_scale[l])
        if not last:
            attn_c = context_attention(qc, kc, vc, attn_sink[l])
            cx = cx + cg1 * mixer_output(attn_c, cuc, puc, w_out[l], conv_dw[l], conv_dw_b[l],
                                         conv_ln_g[l], conv_ln_b[l], pool_w[l], pool_scale[l])

        x = x + g2 * swiglu(rms_norm(x, norm2_g[l]) * (1.0 + sc2) + sh2, w_ffn_in[l], w_ffn_out[l])
        if not last:
            cx = cx + cg2 * swiglu(rms_norm(cx, norm2_g[l]) * (1.0 + csc2) + csh2, w_ffn_in[l], w_ffn_out[l])
    return rms_norm(x, final_g)
```

```cpp
#include <hip/hip_runtime.h>
#include <hip/hip_cooperative_groups.h>
#include <cstdio>
#include <cstdint>
namespace cg = cooperative_groups;
namespace pg8 {
#define PG8_LAS __attribute__((address_space(3)))
typedef unsigned short bf16_t;
typedef short bf16x8 __attribute__((ext_vector_type(8)));
typedef float f32x4 __attribute__((ext_vector_type(4)));
typedef unsigned u32x4 __attribute__((ext_vector_type(4)));
constexpr int BM = 256, BK = 64, HALF = 128, HTB = HALF * BK * 2  , STAGE_BYTES = 8 * HTB, NXCD = 8, WGM = 8;

__host__ __device__ __forceinline__ int lds_byte(int r, int c) { const int st = (r >> 4) * 2 + (c >> 5), rr = r & 15, cc = c & 31, ob = rr * 64 + cc * 2; return st * 1024 + (ob ^ (((ob >> 9) & 1) << 5)); }
__host__ __device__ __forceinline__ void stage_rc(int b, int& R, int& C) { const int st = b / 1024, sb = b % 1024, swz = sb ^ (((sb >> 9) & 1) << 5); R = (st >> 1) * 16 + swz / 64; C = (st & 1) * 32 + (swz % 64) / 2; }
__host__ __device__ __forceinline__ int perm32(int rho) { const int n = rho >> 4, i = rho & 15; return 8 * (i >> 2) + 4 * n + (i & 3); }

struct Unit { int pm, pn; };
struct Gemm { const bf16_t* A; const bf16_t* Bt; int M, N, K; };

struct StaticOrder {
    int nM, nN, nwg, G, c;
    __host__ __device__ void init(int M, int N, int G_, int c_) { nM = M / BM; nN = N / BM; nwg = nM * nN; G = G_; c = c_; }
    __host__ __device__ bool next(int i, Unit& u) const {
        const long L = (long)i * G + c; if (L >= nwg) return false;
        int wgid = (int)L; { const int q = nwg / NXCD, r = nwg % NXCD, xcd = wgid % NXCD, off = wgid / NXCD; wgid = (xcd < r ? xcd * (q + 1) : r * (q + 1) + (xcd - r) * q) + off; }
        const int nig = WGM * nN, gid = wgid / nig, fm = gid * WGM, gsz = (nM - fm) < WGM ? (nM - fm) : WGM;
        u.pm = fm + ((wgid % nig) % gsz); u.pn = (wgid % nig) / gsz; return true;
    }
    __device__ __forceinline__ void a_ready(const Unit&) const {}
    __device__ __forceinline__ void done(const Unit&) const {}
};

__device__ __forceinline__ unsigned cvt_pk_bf16(float lo, float hi) { unsigned r; asm volatile("v_cvt_pk_bf16_f32 %0, %1, %2" : "=v"(r) : "v"(lo), "v"(hi)); return r; }
typedef float f32x2 __attribute__((ext_vector_type(2)));
constexpr float QSCALE = 0.125f * 1.4426950408889634f;
struct EpiInProj {
    static constexpr bool PERM = true, AFTER_DRAIN = false;
    bf16_t* U; const float* rope;
    __device__ __forceinline__ void operator()(const f32x4 (&acc)[2][2][4][2], const Unit& u, int wr, int wc, int fr, int fq) const {
        const bool latent = u.pm < 256;
        const int row0 = u.pm * BM + wr * 64 + fr;
        const bool dorope = latent && (u.pn <= 2);
        const float sgn = (fq >> 1) ? 1.f : -1.f;
#pragma unroll
        for (int ai = 0; ai < 2; ++ai)
#pragma unroll
            for (int m = 0; m < 4; ++m) {
                const int row = row0 + ai * HALF + m * 16;
                const int pos = row & 2047; const int p = (wc & 1) ? (pos & 63) : (pos >> 6);
                f32x4 c0 = {1.f, 1.f, 1.f, 1.f}, c1 = c0, s0 = {0.f, 0.f, 0.f, 0.f}, s1 = s0;
                if (dorope) { const float* rp = rope + p * 16 + 8 * (fq & 1); c0 = *(const f32x4*)rp; c1 = *(const f32x4*)(rp + 4); s0 = *(const f32x4*)(rp + 1024); s1 = *(const f32x4*)(rp + 1028); }
#pragma unroll
                for (int bj = 0; bj < 2; ++bj) {
                    const int colw = u.pn * BM + bj * HALF + wc * 32;
                    f32x4 v0 = acc[ai][bj][m][0], v1 = acc[ai][bj][m][1];
                    if (dorope && colw < 640) {
                        f32x4 p0, p1;
#pragma unroll
                        for (int e = 0; e < 4; ++e) { p0[e] = __shfl_xor(v0[e], 32); p1[e] = __shfl_xor(v1[e], 32); }
                        v0 = v0 * c0 + (p0 * s0) * sgn; v1 = v1 * c1 + (p1 * s1) * sgn;
                    }
                    if (colw < 512) { v0 = v0 * QSCALE; v1 = v1 * QSCALE; }
                    u32x4 w; w.x = cvt_pk_bf16(v0[0], v0[1]); w.y = cvt_pk_bf16(v0[2], v0[3]); w.z = cvt_pk_bf16(v1[0], v1[1]); w.w = cvt_pk_bf16(v1[2], v1[3]);
                    *(u32x4*)(U + (size_t)row * 1536 + colw + 8 * fq) = w;
                }
            }
    }
};
struct EpiResid {
    static constexpr bool PERM = false, AFTER_DRAIN = false;
    const float* srcL; const float* srcC; float* dst; const float* gate;
    __device__ __forceinline__ void operator()(const f32x4 (&acc)[2][2][4][2], const Unit& u, int wr, int wc, int fr, int fq) const {
        const bool latent = u.pm < 256;
        const int mrow = latent ? (u.pm >> 3) : 32;
        const int col0 = u.pn * BM + wc * 32 + 4 * fq;
        const float* gp = gate + (size_t)mrow * 12288 + col0;
        f32x4 gv[2][2];
#pragma unroll
        for (int bj = 0; bj < 2; ++bj)
#pragma unroll
            for (int n = 0; n < 2; ++n) gv[bj][n] = *(const f32x4*)(gp + bj * HALF + n * 16);
        const int row0 = u.pm * BM + wr * 64 + fr;
        const float* src = latent ? srcL : (srcC - (size_t)65536 * 1024);
#pragma unroll
        for (int ai = 0; ai < 2; ++ai)
#pragma unroll
            for (int m = 0; m < 4; ++m) {
                const size_t off = (size_t)(row0 + ai * HALF + m * 16) * 1024 + col0;
#pragma unroll
                for (int bj = 0; bj < 2; ++bj)
#pragma unroll
                    for (int n = 0; n < 2; ++n) { const f32x4 r = *(const f32x4*)(src + off + bj * HALF + n * 16); *(f32x4*)(dst + off + bj * HALF + n * 16) = r + gv[bj][n] * acc[ai][bj][m][n]; }
            }
    }
};
struct EpiSwiGLU {
    static constexpr bool PERM = true, AFTER_DRAIN = false;
    bf16_t* O;
    __device__ __forceinline__ void operator()(const f32x4 (&acc)[2][2][4][2], const Unit& u, int wr, int wc, int fr, int fq) const {
        const int row0 = u.pm * BM + wr * 64 + fr; const int col0 = u.pn * HALF + wc * 32 + 8 * fq;
#pragma unroll
        for (int ai = 0; ai < 2; ++ai)
#pragma unroll
            for (int m = 0; m < 4; ++m) {
                f32x4 h[2];
#pragma unroll
                for (int n = 0; n < 2; ++n) { const f32x4 g = acc[ai][0][m][n], uu = acc[ai][1][m][n];
#pragma unroll
                    for (int e = 0; e < 4; ++e) { const float ex = __builtin_amdgcn_exp2f(g[e] * -1.4426950408889634f); h[n][e] = g[e] * uu[e] * __builtin_amdgcn_rcpf(1.0f + ex); } }
                u32x4 w; w.x = cvt_pk_bf16(h[0][0], h[0][1]); w.y = cvt_pk_bf16(h[0][2], h[0][3]); w.z = cvt_pk_bf16(h[1][0], h[1][1]); w.w = cvt_pk_bf16(h[1][2], h[1][3]);
                *(u32x4*)(O + (size_t)(row0 + ai * HALF + m * 16) * 2816 + col0) = w;
            }
    }
};
struct EpiMod {
    static constexpr bool PERM = false, AFTER_DRAIN = false;
    float* out; const float* bias;
    __device__ __forceinline__ void operator()(const f32x4 (&acc)[2][2][4][2], const Unit& u, int wr, int wc, int fr, int fq) const {
        if (wr != 0) return;
        const int col0 = u.pn * BM + wc * 32 + 4 * fq;
#pragma unroll
        for (int m = 0; m < 3; ++m) { const int row = m * 16 + fr;
            if (row < 33) {
#pragma unroll
                for (int bj = 0; bj < 2; ++bj)
#pragma unroll
                    for (int n = 0; n < 2; ++n) { const int c = col0 + bj * HALF + n * 16; *(f32x4*)(out + (size_t)row * 12288 + c) = acc[0][bj][m][n] + *(const f32x4*)(bias + c); }
            } }
    }
};
struct SchedMod {
    int c;
    __device__ bool next(int i, Unit& u) const { if (i != 0 || c >= 48) return false; u.pm = 0; u.pn = c; return true; }
    __device__ __forceinline__ void a_ready(const Unit&) const {}
    __device__ __forceinline__ void done(const Unit&) const {}
};
template <class Epi, class Sched, bool ALIGN_EPI = false, bool SP2 = false>
__device__ __forceinline__ void gemm_phase(PG8_LAS unsigned char* lds, const Gemm g, const Sched& S, const Epi& E) {
    int tid_ = threadIdx.x; asm volatile("" : "+v"(tid_));
    const int tid = tid_, wid = __builtin_amdgcn_readfirstlane(tid >> 6), lane = tid & 63, wr = wid >> 2, wc = wid & 3, fr = lane & 15, fq = lane >> 4;
    const int K = g.K, nt = K / BK;
    unsigned voffA[2], voffB[2];
#pragma unroll
    for (int i = 0; i < 2; ++i) { int R, C; stage_rc(tid * 16 + i * 8192, R, C); const int Rb = Epi::PERM ? ((R & ~31) + perm32(R & 31)) : R;
        voffA[i] = (unsigned)(R * K + C) * 2u; voffB[i] = (unsigned)(Rb * K + C) * 2u; }
    const size_t kstep = (size_t)(BK * 2);
    const size_t hstep = (size_t)HALF * K * 2;
    const size_t tstep = 2 * hstep;
    const unsigned ldsw = (unsigned)wid * 1024u;
    const int aoff = lds_byte(wr * 64 + fr, fq * 8), boff = lds_byte(wc * 32 + fr, fq * 8);
#define PG8_SA(b, h) (((b) * 2 + (h)) * HTB)
#define PG8_SB(b, h) ((4 + (b) * 2 + (h)) * HTB)
#define PG8_STAGE(bufoff, gbase, voff) do { _Pragma("unroll") for (int _i = 0; _i < 2; ++_i) \
        __builtin_amdgcn_global_load_lds((const unsigned*)((const char*)(gbase) + (voff)[_i]), (PG8_LAS unsigned*)(lds + (bufoff) + ldsw + _i * 8192), 16, 0, 0); } while (0)
#define PG8_LDA(dst, b, h) do { _Pragma("unroll") for (int m = 0; m < 4; ++m) _Pragma("unroll") for (int k = 0; k < 2; ++k) dst[m][k] = *(const PG8_LAS bf16x8*)(lds + PG8_SA(b, h) + aoff + m * 2048 + k * 1024); } while (0)
#define PG8_LDB(dst, b, h) do { _Pragma("unroll") for (int n = 0; n < 2; ++n) _Pragma("unroll") for (int k = 0; k < 2; ++k) dst[n][k] = *(const PG8_LAS bf16x8*)(lds + PG8_SB(b, h) + boff + n * 2048 + k * 1024); } while (0)
#define PG8_MMA(ai, bj, At, Bt) do { __builtin_amdgcn_s_setprio(1); _Pragma("unroll") for (int m = 0; m < 4; ++m) _Pragma("unroll") for (int n = 0; n < 2; ++n) _Pragma("unroll") for (int k = 0; k < 2; ++k) \
        acc[ai][bj][m][n] = __builtin_amdgcn_mfma_f32_16x16x32_bf16(Bt[n][k], At[m][k], acc[ai][bj][m][n], 0, 0, 0); __builtin_amdgcn_s_setprio(0); } while (0)
#define PG8_WAIT_V(n) asm volatile("s_waitcnt vmcnt(" #n ")" ::: "memory")
#define PG8_WAIT_L(n) asm volatile("s_waitcnt lgkmcnt(" #n ")" ::: "memory")
#define PG8_BAR __builtin_amdgcn_s_barrier()
#define PG8_SCHED __builtin_amdgcn_sched_barrier(0)
    Unit cur, nxt; int ui = 0;
    if (!S.next(0, cur)) return;
    f32x4 acc[2][2][4][2];
#pragma unroll
    for (int a = 0; a < 2; ++a)
#pragma unroll
        for (int b = 0; b < 2; ++b)
#pragma unroll
            for (int m = 0; m < 4; ++m)
#pragma unroll
                for (int n = 0; n < 2; ++n) acc[a][b][m][n] = (f32x4){0.f, 0.f, 0.f, 0.f};
    bf16x8 At[4][2], B0[2][2], B1[2][2];
    const char* cA = (const char*)g.A + (size_t)cur.pm * tstep; const char* cB = (const char*)g.Bt + (size_t)cur.pn * tstep;
    S.a_ready(cur);
    if constexpr (SP2) {
        PG8_STAGE(PG8_SB(0, 0), cB, voffB); PG8_STAGE(PG8_SB(0, 1), cB + hstep, voffB); PG8_STAGE(PG8_SA(0, 0), cA, voffA); PG8_STAGE(PG8_SA(0, 1), cA + hstep, voffA);
        if (wr == 1) PG8_BAR;
        PG8_WAIT_V(2); PG8_BAR;
        PG8_STAGE(PG8_SB(1, 0), cB + kstep, voffB); PG8_STAGE(PG8_SA(1, 0), cA + kstep, voffA); PG8_STAGE(PG8_SB(1, 1), cB + hstep + kstep, voffB);
        PG8_WAIT_V(6); PG8_BAR;
    } else {
        PG8_STAGE(PG8_SB(0, 0), cB, voffB); PG8_STAGE(PG8_SA(0, 0), cA, voffA); PG8_STAGE(PG8_SB(0, 1), cB + hstep, voffB); PG8_STAGE(PG8_SA(0, 1), cA + hstep, voffA);
        if (wr == 1) PG8_BAR;
        PG8_WAIT_V(4); PG8_BAR;
        PG8_STAGE(PG8_SB(1, 0), cB + kstep, voffB); PG8_STAGE(PG8_SA(1, 0), cA + kstep, voffA); PG8_STAGE(PG8_SB(1, 1), cB + hstep + kstep, voffB);
        PG8_WAIT_V(6); PG8_BAR;
    }
    for (;;) {
        const bool has_next = S.next(ui + 1, nxt);
        const char* nA = has_next ? (const char*)g.A + (size_t)nxt.pm * tstep : cA; const char* nB = has_next ? (const char*)g.Bt + (size_t)nxt.pn * tstep : cB;
        for (int t = 0; t < nt; t += 2) {
            const bool last = (t == nt - 2);
            const char* a1 = cA + (size_t)(t + 1) * kstep;
            const char* a2 = last ? nA : cA + (size_t)(t + 2) * kstep; const char* b2 = last ? nB : cB + (size_t)(t + 2) * kstep;
            const char* a3 = a2 + kstep; const char* b3 = b2 + kstep;
            if (last && has_next) S.a_ready(nxt);
            if constexpr (SP2) {
            PG8_LDB(B0, 0, 0); PG8_LDB(B1, 0, 1); PG8_SCHED; PG8_LDA(At, 0, 0); PG8_STAGE(PG8_SA(1, 1), a1 + hstep, voffA);
            PG8_WAIT_V(8); PG8_WAIT_L(0); PG8_BAR; PG8_MMA(0, 0, At, B0); PG8_MMA(0, 1, At, B1); PG8_BAR; PG8_SCHED;
            PG8_LDA(At, 0, 1); PG8_STAGE(PG8_SB(0, 0), b2, voffB); PG8_STAGE(PG8_SB(0, 1), b2 + hstep, voffB); PG8_STAGE(PG8_SA(0, 0), a2, voffA);
            PG8_WAIT_V(8); PG8_WAIT_L(0); PG8_BAR; PG8_MMA(1, 0, At, B0); PG8_MMA(1, 1, At, B1); PG8_BAR; PG8_SCHED;
            PG8_LDB(B0, 1, 0); PG8_LDB(B1, 1, 1); PG8_SCHED; PG8_LDA(At, 1, 0); PG8_STAGE(PG8_SA(0, 1), a2 + hstep, voffA);
            PG8_WAIT_V(8); PG8_WAIT_L(0); PG8_BAR; PG8_MMA(0, 0, At, B0); PG8_MMA(0, 1, At, B1); PG8_BAR; PG8_SCHED;
            PG8_LDA(At, 1, 1); PG8_STAGE(PG8_SB(1, 0), b3, voffB); PG8_STAGE(PG8_SB(1, 1), b3 + hstep, voffB); PG8_STAGE(PG8_SA(1, 0), a3, voffA);
            PG8_WAIT_V(8); PG8_WAIT_L(0); PG8_BAR; PG8_MMA(1, 0, At, B0); PG8_MMA(1, 1, At, B1); PG8_BAR; PG8_SCHED;
            } else {
            PG8_LDB(B0, 0, 0); PG8_SCHED; PG8_LDA(At, 0, 0); PG8_STAGE(PG8_SA(1, 1), a1 + hstep, voffA);
            PG8_WAIT_L(8); PG8_BAR; PG8_WAIT_L(0); PG8_MMA(0, 0, At, B0); PG8_BAR; PG8_SCHED;
            PG8_LDB(B1, 0, 1); PG8_STAGE(PG8_SB(0, 0), b2, voffB);
            PG8_BAR; PG8_WAIT_L(0); PG8_MMA(0, 1, At, B1); PG8_BAR;
            PG8_LDA(At, 0, 1); PG8_STAGE(PG8_SA(0, 0), a2, voffA);
            PG8_BAR; PG8_WAIT_L(0); PG8_MMA(1, 0, At, B0); PG8_BAR; PG8_SCHED;
            PG8_STAGE(PG8_SB(0, 1), b2 + hstep, voffB);
            PG8_WAIT_V(6); PG8_BAR; PG8_MMA(1, 1, At, B1); PG8_BAR;
            PG8_LDB(B0, 1, 0); PG8_SCHED; PG8_LDA(At, 1, 0); PG8_STAGE(PG8_SA(0, 1), a2 + hstep, voffA);
            PG8_WAIT_L(8); PG8_BAR; PG8_WAIT_L(0); PG8_MMA(0, 0, At, B0); PG8_BAR; PG8_SCHED;
            PG8_LDB(B1, 1, 1); PG8_STAGE(PG8_SB(1, 0), b3, voffB);
            PG8_BAR; PG8_WAIT_L(0); PG8_MMA(0, 1, At, B1); PG8_BAR;
            PG8_LDA(At, 1, 1); PG8_STAGE(PG8_SA(1, 0), a3, voffA);
            PG8_BAR; PG8_WAIT_L(0); PG8_MMA(1, 0, At, B0); PG8_BAR; PG8_SCHED;
            PG8_STAGE(PG8_SB(1, 1), b3 + hstep, voffB);
            PG8_WAIT_V(6); PG8_BAR; PG8_MMA(1, 1, At, B1); PG8_BAR;
            }
        }
        if constexpr (ALIGN_EPI) { if (wr == 0) PG8_BAR; }
        if constexpr (!Epi::AFTER_DRAIN) { E(acc, cur, wr, wc, fr, fq); S.done(cur); }
        if (!has_next) break;
#pragma unroll
        for (int a = 0; a < 2; ++a)
#pragma unroll
            for (int b = 0; b < 2; ++b)
#pragma unroll
                for (int m = 0; m < 4; ++m)
#pragma unroll
                    for (int n = 0; n < 2; ++n) acc[a][b][m][n] = (f32x4){0.f, 0.f, 0.f, 0.f};
        cur = nxt; cA = nA; cB = nB; ++ui;
        if constexpr (ALIGN_EPI) { if (wr == 1) PG8_BAR; }
    }
    PG8_WAIT_V(0);
    if constexpr (!ALIGN_EPI) { if (wr == 0) PG8_BAR; }
    PG8_BAR;
    if constexpr (Epi::AFTER_DRAIN) { E.fused(acc, cur, wr, wc, fr, fq, lds, wid, lane); S.done(cur); }
#undef PG8_SA
#undef PG8_SB
#undef PG8_STAGE
#undef PG8_LDA
#undef PG8_LDB
#undef PG8_MMA
#undef PG8_WAIT_V
#undef PG8_WAIT_L
#undef PG8_BAR
#undef PG8_SCHED
}
}

constexpr int DM = 1024, NBATCH = 32, SEQ = 2048, NCTX = 256;
constexpr int ML = NBATCH * SEQ, MC = NBATCH * NCTX, MT = ML + MC;
constexpr int INW = 1536, DFF = 2816, NMOD = 6144;
constexpr float EPS = 1e-6f;
constexpr int NWAVES = 8;
#ifndef MK_SPLIT
#define MK_SPLIT 0
#endif

constexpr size_t MiB = 1u << 20;
constexpr size_t WS_ROPE = 1 * MiB, WS_MOD = 2 * MiB, WS_AMOD = 4 * MiB, WS_WMODT = 8 * MiB, WS_WINT = 32 * MiB, WS_WOUTT = 38 * MiB, WS_WF1T = 42 * MiB, WS_WF2T = 64 * MiB;
constexpr size_t WS_XS = 80 * MiB, WS_H = 368 * MiB, WS_U = 512 * MiB, WS_CAT = 728 * MiB, WS_ACT = 512 * MiB, WS_END = 908 * MiB;
static_assert(WS_XS + (size_t)MT * DM * 4 <= WS_H && WS_H + (size_t)MT * DM * 2 <= WS_U && WS_U + (size_t)MT * INW * 2 <= WS_CAT && WS_CAT + (size_t)MT * DM * 2 <= WS_END && WS_ACT + (size_t)MT * DFF * 2 <= WS_END, "ws map");
static_assert(WS_WF2T + (size_t)2 * DM * DFF * 2 <= WS_XS && WS_WF1T + (size_t)2 * 2 * DFF * DM * 2 <= WS_WF2T && WS_WMODT + (size_t)2 * NMOD * DM * 2 <= WS_WINT, "ws map (weights)");

constexpr int RING_BYTES = 131072, LDS_BYTES = 147456;

#define LAS __attribute__((address_space(3)))
typedef unsigned short bf16;
typedef unsigned v4u __attribute__((ext_vector_type(4)));
typedef unsigned v2u __attribute__((ext_vector_type(2)));
typedef float f32x4 __attribute__((ext_vector_type(4)));
typedef float f32x16 __attribute__((ext_vector_type(16)));
typedef short bf16x8 __attribute__((ext_vector_type(8)));
typedef float f32x2_t __attribute__((ext_vector_type(2)));
typedef __bf16 bf16x2_t __attribute__((ext_vector_type(2)));
__device__ __forceinline__ unsigned pk2(float lo, float hi) { f32x2_t v = {lo, hi}; bf16x2_t b = __builtin_convertvector(v, bf16x2_t); return __builtin_bit_cast(unsigned, b); }
__device__ __forceinline__ float bflo(unsigned w) { return __uint_as_float(w << 16); }
__device__ __forceinline__ float bfhi(unsigned w) { return __uint_as_float(w & 0xffff0000u); }
__device__ __forceinline__ float wave_sum(float v) {
#pragma unroll
    for (int o = 1; o < 64; o <<= 1) v += __shfl_xor(v, o);
    return v;
}
__device__ __forceinline__ float silu_f(float v) { return v / (1.0f + __expf(-v)); }

struct Params {
    const float *x, *c, *ctx, *c_ctx, *w_mod, *b_mod, *n1g, *n2g, *w_in, *cdw, *cdwb, *clng, *clnb, *sink, *poolw, *pools, *w_out, *wf1, *wf2, *fing;
    float* out; unsigned char* ws;
    int ph_lo, ph_hi;
};

__device__ __forceinline__ void tr_item(const float* W, int ldw, bf16* WT, int ldt, int k0, int n0, int drow0, LAS float* scr, int lane) {
#pragma unroll 8
    for (int i = 0; i < 32; ++i) { const int kk = 2 * i + (lane >> 5); scr[kk * 33 + (lane & 31)] = W[(size_t)(k0 + kk) * ldw + n0 + (lane & 31)]; }
    asm volatile("s_waitcnt lgkmcnt(0)" ::: "memory");
    const int c = lane & 7;
#pragma unroll
    for (int j = 0; j < 4; ++j) { const int n = (lane >> 3) + 8 * j; const LAS float* s = scr + (8 * c) * 33 + n;
        v4u o; o.x = pk2(s[0 * 33], s[1 * 33]); o.y = pk2(s[2 * 33], s[3 * 33]); o.z = pk2(s[4 * 33], s[5 * 33]); o.w = pk2(s[6 * 33], s[7 * 33]);
        *(v4u*)(WT + (size_t)(drow0 + n) * ldt + k0 + 8 * c) = o; }
    asm volatile("s_waitcnt lgkmcnt(0)" ::: "memory");
}
__device__ __forceinline__ void fold_item(const float* wout, const float* pw, const float* ps, bf16* WoutT, int g, int nc, int lane) {
    const int n = nc * 64 + lane;
    float w[64];
#pragma unroll
    for (int d = 0; d < 64; ++d) w[d] = wout[(size_t)(768 + 64 * g + d) * 1024 + n] * ps[64 * g + d];
    const float* pg = pw + (size_t)g * 4096;
    for (int c8 = 0; c8 < 8; ++c8) {
        float a[8];
#pragma unroll
        for (int cc = 0; cc < 8; ++cc) { const float* pr = pg + (c8 * 8 + cc) * 64; float s = 0.f;
#pragma unroll
            for (int d = 0; d < 64; ++d) s = fmaf(pr[d], w[d], s);
            a[cc] = s; }
        v4u o; o.x = pk2(a[0], a[1]); o.y = pk2(a[2], a[3]); o.z = pk2(a[4], a[5]); o.w = pk2(a[6], a[7]);
        *(v4u*)(WoutT + (size_t)n * 1024 + 768 + 64 * g + c8 * 8) = o;
    }
}

__device__ __forceinline__ void phase_p0a(const Params& P, LAS unsigned char* lds, int G, int tid, int wave, int lane) {
    unsigned char* ws = P.ws;
    LAS float* scr = (LAS float*)(lds + wave * 16384);
    const int gw = blockIdx.x * NWAVES + wave, NGW = G * NWAVES;
    bf16* WmodT = (bf16*)(ws + WS_WMODT);
    for (int it = gw; it < 2 * 3072; it += NGW) { const int l = it / 3072, r = it % 3072, kb = r / 192, nb = r % 192;
        tr_item(P.w_mod + (size_t)l * 1024 * NMOD, NMOD, WmodT, 1024, 64 * kb, 32 * nb, l * NMOD + 32 * nb, scr, lane); }
    const int gt = blockIdx.x * 512 + tid, GT = G * 512;
    bf16* Amod = (bf16*)(ws + WS_AMOD);
    for (int i = gt; i < 256 * 128; i += GT) { const int row = i >> 7, c8 = (i & 127) * 8; v4u o = {0u, 0u, 0u, 0u};
        if (row < 33) { const float* s = (row < 32 ? P.c + (size_t)row * 1024 : P.c_ctx) + c8; const f32x4 a = *(const f32x4*)s, b = *(const f32x4*)(s + 4);
            o.x = pk2(silu_f(a[0]), silu_f(a[1])); o.y = pk2(silu_f(a[2]), silu_f(a[3])); o.z = pk2(silu_f(b[0]), silu_f(b[1])); o.w = pk2(silu_f(b[2]), silu_f(b[3])); }
        *(v4u*)(Amod + (size_t)row * 1024 + c8) = o; }
    float* rope = (float*)(ws + WS_ROPE);
    if (gt < 1024) { const int p = gt >> 4, i = gt & 15; const float inv = powf(10000.0f, -(float)(2 * i) / 32.0f); const float ang = (float)p * inv; float sn, cs; sincosf(ang, &sn, &cs); rope[gt] = cs; rope[1024 + gt] = sn; }
}
__device__ __forceinline__ void phase_p0b_convert(const Params& P, LAS unsigned char* lds, int G, int wave, int lane) {
    unsigned char* ws = P.ws;
    LAS float* scr = (LAS float*)(lds + wave * 16384);
    const int gw = ((int)blockIdx.x - 48) * NWAVES + wave, NGW = (G - 48) * NWAVES;
    constexpr int I_IN = 16 * 48, I_OUT = 12 * 32, I_F1 = 16 * 176, I_F2 = 44 * 32, I_FOLD = 64, I_L = I_IN + I_OUT + I_F1 + I_F2 + I_FOLD;
    for (int it = gw; it < 2 * I_L; it += NGW) {
        const int l = it / I_L; int r = it % I_L;
        if (r < I_FOLD) { fold_item(P.w_out + (size_t)l * 1024 * 1024, P.poolw + (size_t)l * 4 * 4096, P.pools + l * 256, (bf16*)(ws + WS_WOUTT) + (size_t)l * 1024 * 1024, r >> 4, r & 15, lane); continue; } r -= I_FOLD;
        if (r < I_IN) { const int kb = r / 48, nb = r % 48; tr_item(P.w_in + (size_t)l * 1024 * INW, INW, (bf16*)(ws + WS_WINT) + (size_t)l * INW * 1024, 1024, 64 * kb, 32 * nb, 32 * nb, scr, lane); continue; } r -= I_IN;
        if (r < I_OUT) { const int kb = r / 32, nb = r % 32; tr_item(P.w_out + (size_t)l * 1024 * 1024, 1024, (bf16*)(ws + WS_WOUTT) + (size_t)l * 1024 * 1024, 1024, 64 * kb, 32 * nb, 32 * nb, scr, lane); continue; } r -= I_OUT;
        if (r < I_F1) { const int kb = r / 176, nb = r % 176; const int n0 = 32 * nb; const int isu = n0 >= DFF; const int nn = n0 - isu * DFF; const int drow = 256 * (nn / 128) + 128 * isu + (nn % 128);
            tr_item(P.wf1 + (size_t)l * 1024 * 2 * DFF, 2 * DFF, (bf16*)(ws + WS_WF1T) + (size_t)l * 2 * DFF * 1024, 1024, 64 * kb, n0, drow, scr, lane); continue; } r -= I_F1;
        { const int kb = r / 32, nb = r % 32; tr_item(P.wf2 + (size_t)l * DFF * 1024, 1024, (bf16*)(ws + WS_WF2T) + (size_t)l * 1024 * DFF, DFF, 64 * kb, 32 * nb, 32 * nb, scr, lane); }
    }
}

__device__ __forceinline__ void phase_norm(const float* srcL, const float* srcC, bf16* H, const float* gvec, const float* mod_sh, const float* mod_sc, int nrows, int G, int wave, int lane) {
    const int gw = blockIdx.x * NWAVES + wave, NGW = G * NWAVES;
    for (int row = gw; row < nrows; row += NGW) {
        const bool latent = row < ML; const int mrow = latent ? (row >> 11) : 32;
        const f32x4* xr = (const f32x4*)(latent ? srcL + (size_t)row * DM : srcC + (size_t)(row - ML) * DM) + lane;
        f32x4 v[4]; float s = 0.f;
#pragma unroll
        for (int j = 0; j < 4; ++j) { v[j] = xr[64 * j]; s += (v[j].x * v[j].x + v[j].y * v[j].y) + (v[j].z * v[j].z + v[j].w * v[j].w); }
        const float rstd = rsqrtf(wave_sum(s) * (1.f / DM) + EPS);
        v2u* o8 = (v2u*)(H + (size_t)row * DM) + lane;
#pragma unroll
        for (int j = 0; j < 4; ++j) { const int col = 4 * (lane + 64 * j);
            const f32x4 g = *(const f32x4*)(gvec + col), sc = *(const f32x4*)(mod_sc + (size_t)mrow * 12288 + col), sh = *(const f32x4*)(mod_sh + (size_t)mrow * 12288 + col);
            const f32x4 y = (v[j] * rstd) * g * (sc + 1.0f) + sh;
            v2u o; o.x = pk2(y.x, y.y); o.y = pk2(y.z, y.w); o8[64 * j] = o; }
    }
}
__device__ __forceinline__ void phase_final(const float* src, float* out, const float* gvec, int G, int wave, int lane) {
    const int gw = blockIdx.x * NWAVES + wave, NGW = G * NWAVES;
    for (int row = gw; row < ML; row += NGW) {
        const f32x4* xr = (const f32x4*)(src + (size_t)row * DM) + lane;
        f32x4 v[4]; float s = 0.f;
#pragma unroll
        for (int j = 0; j < 4; ++j) { v[j] = xr[64 * j]; s += (v[j].x * v[j].x + v[j].y * v[j].y) + (v[j].z * v[j].z + v[j].w * v[j].w); }
        const float rstd = rsqrtf(wave_sum(s) * (1.f / DM) + EPS);
        f32x4* o = (f32x4*)(out + (size_t)row * DM) + lane;
#pragma unroll
        for (int j = 0; j < 4; ++j) { const f32x4 g = *(const f32x4*)(gvec + 4 * (lane + 64 * j)); o[64 * j] = (v[j] * rstd) * g; }
    }
}

constexpr int KV_STRIDE = 144;
constexpr int KV_TILE = 64 * KV_STRIDE;
#define MFMA32(a, b, c) __builtin_amdgcn_mfma_f32_32x32x16_bf16((a), (b), (c), 0, 0, 0)
__device__ __forceinline__ int crow(int r, int h) { return (r & 3) + 8 * (r >> 2) + 4 * h; }
__device__ __forceinline__ void attn_unit(LAS unsigned char* lds, const bf16* U, bf16* CAT, const float* sinkp, int unit, int tid, int wave, int lane) {
    const int r32 = lane & 31, h = lane >> 5;
    int b, kvh, p0, qrow0; bool is_lat;
    if (unit < 2048) { b = unit >> 6; kvh = (unit >> 5) & 1; p0 = (unit & 31) * 64; qrow0 = b * SEQ + p0; is_lat = true; }
    else { const int cu = unit - 2048; b = cu >> 3; kvh = (cu >> 2) & 1; p0 = 0; qrow0 = ML + b * NCTX + (cu & 3) * 64; is_lat = false; }
    const int ctxrow0 = ML + b * NCTX;
    int lt_lo = 0, nt = 4;
    if (is_lat) { lt_lo = (p0 >= 128) ? 0 : (p0 >= 64 ? 1 : 2); const int lt_hi = (p0 + 192 <= SEQ) ? 4 : ((p0 + 128 <= SEQ) ? 3 : 2); nt = 4 + lt_hi - lt_lo + 1; }
    const int head = kvh * 4 + (wave >> 1), qi = 32 * (wave & 1) + r32;
    bf16x8 qf[4];
    { const bf16* qp = U + (size_t)(qrow0 + qi) * INW + head * 64 + 8 * h;
#pragma unroll
      for (int d0 = 0; d0 < 4; ++d0) qf[d0] = *(const bf16x8*)(qp + 16 * d0); }
    float m_run = sinkp[head] * 1.4426950408889634f, l_run = (h == 0) ? 1.f : 0.f;
    f32x16 o0, o1;
#pragma unroll
    for (int r = 0; r < 16; ++r) { o0[r] = 0.f; o1[r] = 0.f; }
    const int kkey = tid >> 3, kch = tid & 7;
    const int vkey = tid & 63, vch = tid >> 6;
    const int vslot = (vkey & ~15) + 8 * ((vkey >> 2) & 1) + 4 * ((vkey >> 3) & 1) + (vkey & 3);
    LAS unsigned char* Kb = lds; LAS unsigned char* Vb = lds + 2 * KV_TILE;
    const size_t kcol = 512 + kvh * 64 + kch * 8, vcol = 640 + kvh * 64 + vch * 8;
    v4u kreg, vreg;
#define TILE_ROW(t) ((t) < 4 ? ctxrow0 + 64 * (t) : b * SEQ + p0 - 128 + 64 * (lt_lo + (t) - 4))
#define LOAD_TILE(t) do { const int rb_ = TILE_ROW(t); kreg = *(const v4u*)(U + (size_t)(rb_ + kkey) * INW + kcol); vreg = *(const v4u*)(U + (size_t)(rb_ + vkey) * INW + vcol); } while (0)
#define STORE_TILE(buf) do { *(LAS v4u*)(Kb + (buf) * KV_TILE + kkey * KV_STRIDE + kch * 16) = kreg; \
        LAS unsigned short* vp_ = (LAS unsigned short*)(Vb + (buf) * KV_TILE + (vch * 8) * KV_STRIDE + vslot * 2); \
        vp_[0 * (KV_STRIDE / 2)] = (unsigned short)(vreg.x & 0xffffu); vp_[1 * (KV_STRIDE / 2)] = (unsigned short)(vreg.x >> 16); \
        vp_[2 * (KV_STRIDE / 2)] = (unsigned short)(vreg.y & 0xffffu); vp_[3 * (KV_STRIDE / 2)] = (unsigned short)(vreg.y >> 16); \
        vp_[4 * (KV_STRIDE / 2)] = (unsigned short)(vreg.z & 0xffffu); vp_[5 * (KV_STRIDE / 2)] = (unsigned short)(vreg.z >> 16); \
        vp_[6 * (KV_STRIDE / 2)] = (unsigned short)(vreg.w & 0xffffu); vp_[7 * (KV_STRIDE / 2)] = (unsigned short)(vreg.w >> 16); } while (0)
    __syncthreads();
    LOAD_TILE(0); STORE_TILE(0);
    __syncthreads();
    for (int t = 0; t < nt; ++t) {
        const int buf = t & 1;
        if (t + 1 < nt) LOAD_TILE(t + 1);
        const LAS unsigned char* kb = Kb + buf * KV_TILE + r32 * KV_STRIDE + 16 * h;
        const LAS unsigned char* vb = Vb + buf * KV_TILE + r32 * KV_STRIDE + 16 * h;
        f32x16 s0, s1;
#pragma unroll
        for (int r = 0; r < 16; ++r) { s0[r] = 0.f; s1[r] = 0.f; }
#pragma unroll
        for (int d0 = 0; d0 < 4; ++d0) {
            const bf16x8 k0 = *(const LAS bf16x8*)(kb + 32 * d0), k1 = *(const LAS bf16x8*)(kb + 32 * KV_STRIDE + 32 * d0);
            s0 = MFMA32(k0, qf[d0], s0); s1 = MFMA32(k1, qf[d0], s1);
        }
        int mtype = 0;
        if (t >= 4) { const int lt = lt_lo + t - 4; mtype = (lt == 0) ? 1 : ((lt == 4) ? 2 : 0); }
        if (mtype) {
#pragma unroll
            for (int r = 0; r < 16; ++r) { const int k0 = crow(r, h), k1 = 32 + k0;
                const bool v0 = (mtype == 1) ? (k0 >= qi) : (k0 <= qi), v1 = (mtype == 1) ? (k1 >= qi) : (k1 <= qi);
                if (!v0) s0[r] = -1e30f; if (!v1) s1[r] = -1e30f; }
        }
        float mx = s0[0];
#pragma unroll
        for (int r = 1; r < 16; ++r) mx = fmaxf(mx, s0[r]);
#pragma unroll
        for (int r = 0; r < 16; ++r) mx = fmaxf(mx, s1[r]);
        mx = fmaxf(mx, __shfl_xor(mx, 32));
        const float m_new = fmaxf(m_run, mx), alpha = __builtin_amdgcn_exp2f(m_run - m_new);
        m_run = m_new;
        float ps = 0.f;
#pragma unroll
        for (int r = 0; r < 16; ++r) { s0[r] = __builtin_amdgcn_exp2f(s0[r] - m_new); s1[r] = __builtin_amdgcn_exp2f(s1[r] - m_new); ps += s0[r] + s1[r]; }
        l_run = l_run * alpha + ps;
#pragma unroll
        for (int r = 0; r < 16; ++r) { o0[r] *= alpha; o1[r] *= alpha; }
        v4u pf[4];
        pf[0] = (v4u){pk2(s0[0], s0[1]), pk2(s0[2], s0[3]), pk2(s0[4], s0[5]), pk2(s0[6], s0[7])};
        pf[1] = (v4u){pk2(s0[8], s0[9]), pk2(s0[10], s0[11]), pk2(s0[12], s0[13]), pk2(s0[14], s0[15])};
        pf[2] = (v4u){pk2(s1[0], s1[1]), pk2(s1[2], s1[3]), pk2(s1[4], s1[5]), pk2(s1[6], s1[7])};
        pf[3] = (v4u){pk2(s1[8], s1[9]), pk2(s1[10], s1[11]), pk2(s1[12], s1[13]), pk2(s1[14], s1[15])};
#pragma unroll
        for (int s4 = 0; s4 < 4; ++s4) {
            const bf16x8 v0 = *(const LAS bf16x8*)(vb + 32 * s4), v1 = *(const LAS bf16x8*)(vb + 32 * KV_STRIDE + 32 * s4);
            o0 = MFMA32(v0, __builtin_bit_cast(bf16x8, pf[s4]), o0); o1 = MFMA32(v1, __builtin_bit_cast(bf16x8, pf[s4]), o1);
        }
        if (t + 1 < nt) STORE_TILE(buf ^ 1);
        __syncthreads();
    }
#undef TILE_ROW
#undef LOAD_TILE
#undef STORE_TILE
    const float lt = l_run + __shfl_xor(l_run, 32), inv = 1.0f / lt;
    bf16* op = CAT + (size_t)(qrow0 + qi) * DM + head * 64 + 4 * h;
#pragma unroll
    for (int g4 = 0; g4 < 4; ++g4) {
        v2u w0, w1;
        w0.x = pk2(o0[4 * g4] * inv, o0[4 * g4 + 1] * inv); w0.y = pk2(o0[4 * g4 + 2] * inv, o0[4 * g4 + 3] * inv);
        w1.x = pk2(o1[4 * g4] * inv, o1[4 * g4 + 1] * inv); w1.y = pk2(o1[4 * g4 + 2] * inv, o1[4 * g4 + 3] * inv);
        *(v2u*)(op + 8 * g4) = w0; *(v2u*)(op + 32 + 8 * g4) = w1;
    }
}

__device__ __forceinline__ void convpool_unit(LAS unsigned char* lds, const bf16* U, bf16* CAT, const float* dw, const float* dwb, const float* lng, const float* lnb, int cv, int tid, int wave, int lane) {
    const int row0 = cv * 32; const bool latent = row0 < ML;
    const int seq0 = latent ? (row0 & ~(SEQ - 1)) : ML + ((row0 - ML) & ~(NCTX - 1)); const int slen = latent ? SEQ : NCTX;
    LAS float* hbuf = (LAS float*)lds;
    LAS float* cbuf = (LAS float*)(lds + 62 * 256 * 4);
    __syncthreads();
    { const int ch = tid & 31;
#pragma unroll
      for (int pss = 0; pss < 4; ++pss) { const int rr = pss * 16 + (tid >> 5); if (rr < 62) { const int grow = row0 - 15 + rr;
          f32x4 h0 = {0.f, 0.f, 0.f, 0.f}, h1 = h0;
          if (grow >= seq0 && grow < seq0 + slen) { const bf16* up = U + (size_t)grow * INW + 768 + 8 * ch; const v4u a = *(const v4u*)up, g = *(const v4u*)(up + 256);
#define GLU(A, Gv) ((A) / (1.0f + __expf(-(Gv))))
              h0[0] = GLU(bflo(a.x), bflo(g.x)); h0[1] = GLU(bfhi(a.x), bfhi(g.x)); h0[2] = GLU(bflo(a.y), bflo(g.y)); h0[3] = GLU(bfhi(a.y), bfhi(g.y));
              h1[0] = GLU(bflo(a.z), bflo(g.z)); h1[1] = GLU(bfhi(a.z), bfhi(g.z)); h1[2] = GLU(bflo(a.w), bflo(g.w)); h1[3] = GLU(bfhi(a.w), bfhi(g.w));
#undef GLU
          }
          *(LAS f32x4*)(hbuf + rr * 256 + 8 * ch) = h0; *(LAS f32x4*)(hbuf + rr * 256 + 8 * ch + 4) = h1; } } }
    __syncthreads();
    { const int c = tid & 255, half = tid >> 8;
      float hv[46];
#pragma unroll
      for (int i = 0; i < 46; ++i) hv[i] = hbuf[(half * 16 + i) * 256 + c];
      float acc[16]; const float bias = dwb[c];
#pragma unroll
      for (int o = 0; o < 16; ++o) acc[o] = bias;
#pragma unroll
      for (int j = 0; j < 31; ++j) { const float w = dw[j * 256 + c];
#pragma unroll
          for (int o = 0; o < 16; ++o) acc[o] = fmaf(w, hv[o + j], acc[o]); }
#pragma unroll
      for (int o = 0; o < 16; ++o) cbuf[(half * 16 + o) * 256 + c] = acc[o]; }
    __syncthreads();
    { const f32x4 g = *(const f32x4*)(lng + 4 * lane), bb = *(const f32x4*)(lnb + 4 * lane);
#pragma unroll
      for (int i = 0; i < 4; ++i) { const int r = wave * 4 + i; const f32x4 v = *(const LAS f32x4*)(cbuf + r * 256 + 4 * lane);
          const float mu = wave_sum((v.x + v.y) + (v.z + v.w)) * (1.f / 256.f); const f32x4 d = v - mu;
          const float var = wave_sum((d.x * d.x + d.y * d.y) + (d.z * d.z + d.w * d.w)) * (1.f / 256.f);
          const f32x4 hn = d * rsqrtf(var + EPS) * g + bb;
          v2u o; o.x = pk2(silu_f(hn.x), silu_f(hn.y)); o.y = pk2(silu_f(hn.z), silu_f(hn.w));
          *(v2u*)(CAT + (size_t)(row0 + r) * DM + 512 + 4 * lane) = o; } }
    { const int ch = tid & 31, gi = ch >> 3, win = 2 << gi;
#pragma unroll
      for (int pss = 0; pss < 2; ++pss) { const int row = row0 + pss * 16 + (tid >> 5); const int t = row - seq0;
          int lo = t - (win >> 1); lo = lo < 0 ? 0 : lo; int hi = t + win - 1 - (win >> 1); hi = hi > slen - 1 ? slen - 1 : hi;
          float s[8];
#pragma unroll
          for (int e = 0; e < 8; ++e) s[e] = 0.f;
          const bf16* up = U + (size_t)seq0 * INW + 1280 + 8 * ch;
          for (int r = lo; r <= hi; ++r) { const v4u a = *(const v4u*)(up + (size_t)r * INW);
              s[0] += bflo(a.x); s[1] += bfhi(a.x); s[2] += bflo(a.y); s[3] += bfhi(a.y); s[4] += bflo(a.z); s[5] += bfhi(a.z); s[6] += bflo(a.w); s[7] += bfhi(a.w); }
          const float rc = 1.0f / (float)(hi - lo + 1);
          const v4u x = *(const v4u*)(up + (size_t)t * INW);
          v4u o; o.x = pk2(s[0] * rc - bflo(x.x), s[1] * rc - bfhi(x.x)); o.y = pk2(s[2] * rc - bflo(x.y), s[3] * rc - bfhi(x.y));
          o.z = pk2(s[4] * rc - bflo(x.z), s[5] * rc - bfhi(x.z)); o.w = pk2(s[6] * rc - bflo(x.w), s[7] * rc - bfhi(x.w));
          *(v4u*)(CAT + (size_t)row * DM + 768 + 8 * ch) = o; } }
}

__global__ void __launch_bounds__(NWAVES * 64, 2) fwd_megakernel(Params P) {
    extern __shared__ __attribute__((aligned(16))) unsigned char lds_raw[];
    LAS unsigned char* lds = (LAS unsigned char*)lds_raw;
    cg::grid_group grid = cg::this_grid();
    const int G = gridDim.x;
#define FRESH_TID() int tid = threadIdx.x; asm volatile("" : "+v"(tid)); const int lane = tid & 63, wave = __builtin_amdgcn_readfirstlane(tid >> 6); (void)lane; (void)wave
    unsigned char* ws = P.ws;
    float* rope = (float*)(ws + WS_ROPE); float* modb = (float*)(ws + WS_MOD);
    bf16* Amod = (bf16*)(ws + WS_AMOD); bf16* WmodT = (bf16*)(ws + WS_WMODT);
    float* XS = (float*)(ws + WS_XS); bf16* H = (bf16*)(ws + WS_H); bf16* U = (bf16*)(ws + WS_U); bf16* CAT = (bf16*)(ws + WS_CAT); bf16* ACT = (bf16*)(ws + WS_ACT);
    const int lo = P.ph_lo, hi = P.ph_hi;
    int ph = 0;
#define IN_PH() (lo <= ph && ph < hi)
#define SEAM() do { if (!MK_SPLIT) grid.sync(); ++ph; } while (0)

    if (IN_PH()) { FRESH_TID(); phase_p0a(P, lds, G, tid, wave, lane); }
    SEAM();
    if (IN_PH()) {
        if (blockIdx.x < 48) { pg8::Gemm g{Amod, WmodT, 256, 2 * NMOD, DM}; pg8::SchedMod S{(int)blockIdx.x}; pg8::EpiMod E{modb, P.b_mod};
            pg8::gemm_phase<pg8::EpiMod, pg8::SchedMod, false, true>(lds, g, S, E); }
        else { FRESH_TID(); phase_p0b_convert(P, lds, G, wave, lane); }
    }
    SEAM();
#pragma unroll 1
    for (int l = 0; l < 2; ++l) {
        const bool last = (l == 1);
        const float* mod_l = modb + l * NMOD;
        const float* srcL = (l == 0) ? P.x : XS; const float* srcC = (l == 0) ? P.ctx : XS + (size_t)ML * DM;
        const int Mff = last ? ML : MT;
        if (IN_PH()) { FRESH_TID(); phase_norm(srcL, srcC, H, P.n1g + l * DM, mod_l + 0 * 1024, mod_l + 1 * 1024, MT, G, wave, lane); }
        SEAM();
        if (IN_PH()) { pg8::Gemm g{H, (const bf16*)(ws + WS_WINT) + (size_t)l * INW * DM, MT, INW, DM}; pg8::StaticOrder S; S.init(MT, INW, G, (int)blockIdx.x); pg8::EpiInProj E{U, rope};
            pg8::gemm_phase<pg8::EpiInProj, pg8::StaticOrder, true, true>(lds, g, S, E); }
        SEAM();
        if (IN_PH()) {
            FRESH_TID(); const int NA = last ? 2048 : 2304, NCV = last ? (ML / 32) : (MT / 32);
            for (int u = blockIdx.x; u < NA; u += G) attn_unit(lds, U, CAT, P.sink + l * 8, u, tid, wave, lane);
            for (int u = blockIdx.x; u < NCV; u += G) convpool_unit(lds, U, CAT, P.cdw + l * 31 * 256, P.cdwb + l * 256, P.clng + l * 256, P.clnb + l * 256, u, tid, wave, lane);
        }
        SEAM();
        if (IN_PH()) { pg8::Gemm g{CAT, (const bf16*)(ws + WS_WOUTT) + (size_t)l * DM * DM, Mff, DM, DM}; pg8::StaticOrder S; S.init(Mff, DM, G, (int)blockIdx.x); pg8::EpiResid E{srcL, srcC, XS, mod_l + 2 * 1024};
            pg8::gemm_phase<pg8::EpiResid, pg8::StaticOrder, true, true>(lds, g, S, E); }
        SEAM();
        if (IN_PH()) { FRESH_TID(); phase_norm(XS, XS + (size_t)ML * DM, H, P.n2g + l * DM, mod_l + 3 * 1024, mod_l + 4 * 1024, Mff, G, wave, lane); }
        SEAM();
        if (IN_PH()) { pg8::Gemm g{H, (const bf16*)(ws + WS_WF1T) + (size_t)l * 2 * DFF * DM, Mff, 2 * DFF, DM}; pg8::StaticOrder S; S.init(Mff, 2 * DFF, G, (int)blockIdx.x); pg8::EpiSwiGLU E{ACT};
            pg8::gemm_phase<pg8::EpiSwiGLU, pg8::StaticOrder, true, true>(lds, g, S, E); }
        SEAM();
        if (IN_PH()) { pg8::Gemm g{ACT, (const bf16*)(ws + WS_WF2T) + (size_t)l * DM * DFF, Mff, DM, DFF}; pg8::StaticOrder S; S.init(Mff, DM, G, (int)blockIdx.x); pg8::EpiResid E{XS, XS + (size_t)ML * DM, XS, mod_l + 5 * 1024};
            pg8::gemm_phase<pg8::EpiResid, pg8::StaticOrder, true, true>(lds, g, S, E); }
        SEAM();
    }
    if (IN_PH()) { FRESH_TID(); phase_final(XS, P.out, P.fing, G, wave, lane); }
#undef IN_PH
#undef SEAM
}
constexpr int N_PHASES = 2 + 2 * 7 + 1;

extern "C" void kernel_launch(void* const* d_in, const int* in_sizes, int n_in, void* d_out, int out_size, void* d_ws, size_t ws_size, hipStream_t stream) {
    static int grid = 0;
    if (grid == 0) {
        if (n_in != 20 || ws_size < WS_END) { fprintf(stderr, "kernel_launch: unexpected n_in %d or ws_size %zu (need %zu)\n", n_in, ws_size, (size_t)WS_END); grid = -1; return; }
        int dev = 0, cus = 0, per_cu = 0;
        hipGetDevice(&dev); hipDeviceGetAttribute(&cus, hipDeviceAttributeMultiprocessorCount, dev);
        if (hipFuncSetAttribute((const void*)fwd_megakernel, hipFuncAttributeMaxDynamicSharedMemorySize, LDS_BYTES) != hipSuccess) { fprintf(stderr, "kernel_launch: hipFuncSetAttribute failed\n"); grid = -1; return; }
        if (hipOccupancyMaxActiveBlocksPerMultiprocessor(&per_cu, (const void*)fwd_megakernel, NWAVES * 64, LDS_BYTES) != hipSuccess || per_cu < 1) { fprintf(stderr, "kernel_launch: occupancy query says %d\n", per_cu); per_cu = 1; }
        (void)hipGetLastError();
        grid = cus * per_cu;
        if (grid > 256) grid = 256;
        fprintf(stderr, "kernel_launch: grid %d (cus %d, per_cu %d)\n", grid, cus, per_cu);
    }
    if (grid < 0) return;
    Params p{};
    const float** pp = (const float**)&p;
    for (int i = 0; i < 20; ++i) pp[i] = (const float*)d_in[i];
    p.out = (float*)d_out; p.ws = (unsigned char*)d_ws;
#if MK_SPLIT
    for (int k = 0; k < N_PHASES; ++k) { p.ph_lo = k; p.ph_hi = k + 1; hipLaunchKernelGGL(fwd_megakernel, dim3(grid), dim3(NWAVES * 64), LDS_BYTES, stream, p); }
#else
    p.ph_lo = 0; p.ph_hi = N_PHASES;
    void* args[] = {&p};
    hipError_t e = hipLaunchCooperativeKernel((const void*)fwd_megakernel, dim3(grid), dim3(NWAVES * 64), args, LDS_BYTES, stream);
    if (e != hipSuccess) fprintf(stderr, "kernel_launch: cooperative launch failed: %s (grid %d)\n", hipGetErrorString(e), grid);
#endif
}
```

```cpp
#include <hip/hip_runtime.h>
#include <hip/hip_cooperative_groups.h>
#include <cstdio>
#include <cstdint>
namespace cg = cooperative_groups;
namespace pg8 {
#define PG8_LAS __attribute__((address_space(3)))
typedef unsigned short bf16_t;
typedef short bf16x8 __attribute__((ext_vector_type(8)));
typedef float f32x4 __attribute__((ext_vector_type(4)));
typedef unsigned u32x4 __attribute__((ext_vector_type(4)));
constexpr int BM = 256, BK = 64, HALF = 128, HTB = HALF * BK * 2  , STAGE_BYTES = 8 * HTB, NXCD = 8, WGM = 8;

__host__ __device__ __forceinline__ int lds_byte(int r, int c) { const int st = (r >> 4) * 2 + (c >> 5), rr = r & 15, cc = c & 31, ob = rr * 64 + cc * 2; return st * 1024 + (ob ^ (((ob >> 9) & 1) << 5)); }
__host__ __device__ __forceinline__ void stage_rc(int b, int& R, int& C) { const int st = b / 1024, sb = b % 1024, swz = sb ^ (((sb >> 9) & 1) << 5); R = (st >> 1) * 16 + swz / 64; C = (st & 1) * 32 + (swz % 64) / 2; }
__host__ __device__ __forceinline__ int perm32(int rho) { const int n = rho >> 4, i = rho & 15; return 8 * (i >> 2) + 4 * n + (i & 3); }

struct Unit { int pm, pn; };
struct Gemm { const bf16_t* A; const bf16_t* Bt; int M, N, K; };

struct StaticOrder {
    int nM, nN, nwg, G, c;
    __host__ __device__ void init(int M, int N, int G_, int c_) { nM = M / BM; nN = N / BM; nwg = nM * nN; G = G_; c = c_; }
    __host__ __device__ bool next(int i, Unit& u) const {
        const long L = (long)i * G + c; if (L >= nwg) return false;
        int wgid = (int)L; { const int q = nwg / NXCD, r = nwg % NXCD, xcd = wgid % NXCD, off = wgid / NXCD; wgid = (xcd < r ? xcd * (q + 1) : r * (q + 1) + (xcd - r) * q) + off; }
        const int nig = WGM * nN, gid = wgid / nig, fm = gid * WGM, gsz = (nM - fm) < WGM ? (nM - fm) : WGM;
        u.pm = fm + ((wgid % nig) % gsz); u.pn = (wgid % nig) / gsz; return true;
    }
    __device__ __forceinline__ void a_ready(const Unit&) const {}
    __device__ __forceinline__ void done(const Unit&) const {}
};

__device__ __forceinline__ unsigned cvt_pk_bf16(float lo, float hi) { unsigned r; asm volatile("v_cvt_pk_bf16_f32 %0, %1, %2" : "=v"(r) : "v"(lo), "v"(hi)); return r; }
typedef float f32x2 __attribute__((ext_vector_type(2)));
constexpr float QSCALE = 0.125f * 1.4426950408889634f;
struct EpiInProj {
    static constexpr bool PERM = true, AFTER_DRAIN = false;
    bf16_t* U; const float* rope;
    __device__ __forceinline__ void operator()(const f32x4 (&acc)[2][2][4][2], const Unit& u, int wr, int wc, int fr, int fq) const {
        const bool latent = u.pm < 256;
        const int row0 = u.pm * BM + wr * 64 + fr;
        const bool dorope = latent && (u.pn <= 2);
        const float sgn = (fq >> 1) ? 1.f : -1.f;
#pragma unroll
        for (int ai = 0; ai < 2; ++ai)
#pragma unroll
            for (int m = 0; m < 4; ++m) {
                const int row = row0 + ai * HALF + m * 16;
                const int pos = row & 2047; const int p = (wc & 1) ? (pos & 63) : (pos >> 6);
                f32x4 c0 = {1.f, 1.f, 1.f, 1.f}, c1 = c0, s0 = {0.f, 0.f, 0.f, 0.f}, s1 = s0;
                if (dorope) { const float* rp = rope + p * 16 + 8 * (fq & 1); c0 = *(const f32x4*)rp; c1 = *(const f32x4*)(rp + 4); s0 = *(const f32x4*)(rp + 1024); s1 = *(const f32x4*)(rp + 1028); }
#pragma unroll
                for (int bj = 0; bj < 2; ++bj) {
                    const int colw = u.pn * BM + bj * HALF + wc * 32;
                    f32x4 v0 = acc[ai][bj][m][0], v1 = acc[ai][bj][m][1];
                    if (dorope && colw < 640) {
                        f32x4 p0, p1;
#pragma unroll
                        for (int e = 0; e < 4; ++e) { p0[e] = __shfl_xor(v0[e], 32); p1[e] = __shfl_xor(v1[e], 32); }
                        v0 = v0 * c0 + (p0 * s0) * sgn; v1 = v1 * c1 + (p1 * s1) * sgn;
                    }
                    if (colw < 512) { v0 = v0 * QSCALE; v1 = v1 * QSCALE; }
                    u32x4 w; w.x = cvt_pk_bf16(v0[0], v0[1]); w.y = cvt_pk_bf16(v0[2], v0[3]); w.z = cvt_pk_bf16(v1[0], v1[1]); w.w = cvt_pk_bf16(v1[2], v1[3]);
                    *(u32x4*)(U + (size_t)row * 1536 + colw + 8 * fq) = w;
                }
            }
    }
};
struct EpiResid {
    static constexpr bool PERM = false, AFTER_DRAIN = false;
    const float* srcL; const float* srcC; float* dst; const float* gate;
    __device__ __forceinline__ void operator()(const f32x4 (&acc)[2][2][4][2], const Unit& u, int wr, int wc, int fr, int fq) const {
        const bool latent = u.pm < 256;
        const int mrow = latent ? (u.pm >> 3) : 32;
        const int col0 = u.pn * BM + wc * 32 + 4 * fq;
        const float* gp = gate + (size_t)mrow * 12288 + col0;
        f32x4 gv[2][2];
#pragma unroll
        for (int bj = 0; bj < 2; ++bj)
#pragma unroll
            for (int n = 0; n < 2; ++n) gv[bj][n] = *(const f32x4*)(gp + bj * HALF + n * 16);
        const int row0 = u.pm * BM + wr * 64 + fr;
        const float* src = latent ? srcL : (srcC - (size_t)65536 * 1024);
#pragma unroll
        for (int ai = 0; ai < 2; ++ai)
#pragma unroll
            for (int m = 0; m < 4; ++m) {
                const size_t off = (size_t)(row0 + ai * HALF + m * 16) * 1024 + col0;
#pragma unroll
                for (int bj = 0; bj < 2; ++bj)
#pragma unroll
                    for (int n = 0; n < 2; ++n) { const f32x4 r = *(const f32x4*)(src + off + bj * HALF + n * 16); *(f32x4*)(dst + off + bj * HALF + n * 16) = r + gv[bj][n] * acc[ai][bj][m][n]; }
            }
    }
};
struct EpiSwiGLU {
    static constexpr bool PERM = true, AFTER_DRAIN = false;
    bf16_t* O;
    __device__ __forceinline__ void operator()(const f32x4 (&acc)[2][2][4][2], const Unit& u, int wr, int wc, int fr, int fq) const {
        const int row0 = u.pm * BM + wr * 64 + fr; const int col0 = u.pn * HALF + wc * 32 + 8 * fq;
#pragma unroll
        for (int ai = 0; ai < 2; ++ai)
#pragma unroll
            for (int m = 0; m < 4; ++m) {
                f32x4 h[2];
#pragma unroll
                for (int n = 0; n < 2; ++n) { const f32x4 g = acc[ai][0][m][n], uu = acc[ai][1][m][n];
#pragma unroll
                    for (int e = 0; e < 4; ++e) { const float ex = __builtin_amdgcn_exp2f(g[e] * -1.4426950408889634f); h[n][e] = g[e] * uu[e] * __builtin_amdgcn_rcpf(1.0f + ex); } }
                u32x4 w; w.x = cvt_pk_bf16(h[0][0], h[0][1]); w.y = cvt_pk_bf16(h[0][2], h[0][3]); w.z = cvt_pk_bf16(h[1][0], h[1][1]); w.w = cvt_pk_bf16(h[1][2], h[1][3]);
                *(u32x4*)(O + (size_t)(row0 + ai * HALF + m * 16) * 2816 + col0) = w;
            }
    }
};
struct EpiMod {
    static constexpr bool PERM = false, AFTER_DRAIN = false;
    float* out; const float* bias;
    __device__ __forceinline__ void operator()(const f32x4 (&acc)[2][2][4][2], const Unit& u, int wr, int wc, int fr, int fq) const {
        if (wr != 0) return;
        const int col0 = u.pn * BM + wc * 32 + 4 * fq;
#pragma unroll
        for (int m = 0; m < 3; ++m) { const int row = m * 16 + fr;
            if (row < 33) {
#pragma unroll
                for (int bj = 0; bj < 2; ++bj)
#pragma unroll
                    for (int n = 0; n < 2; ++n) { const int c = col0 + bj * HALF + n * 16; *(f32x4*)(out + (size_t)row * 12288 + c) = acc[0][bj][m][n] + *(const f32x4*)(bias + c); }
            } }
    }
};
struct SchedMod {
    int c;
    __device__ bool next(int i, Unit& u) const { if (i != 0 || c >= 48) return false; u.pm = 0; u.pn = c; return true; }
    __device__ __forceinline__ void a_ready(const Unit&) const {}
    __device__ __forceinline__ void done(const Unit&) const {}
};
template <class Epi, class Sched, bool ALIGN_EPI = false, bool SP2 = false>
__device__ __forceinline__ void gemm_phase(PG8_LAS unsigned char* lds, const Gemm g, const Sched& S, const Epi& E) {
    int tid_ = threadIdx.x; asm volatile("" : "+v"(tid_));
    const int tid = tid_, wid = __builtin_amdgcn_readfirstlane(tid >> 6), lane = tid & 63, wr = wid >> 2, wc = wid & 3, fr = lane & 15, fq = lane >> 4;
    const int K = g.K, nt = K / BK;
    unsigned voffA[2], voffB[2];
#pragma unroll
    for (int i = 0; i < 2; ++i) { int R, C; stage_rc(tid * 16 + i * 8192, R, C); const int Rb = Epi::PERM ? ((R & ~31) + perm32(R & 31)) : R;
        voffA[i] = (unsigned)(R * K + C) * 2u; voffB[i] = (unsigned)(Rb * K + C) * 2u; }
    const size_t kstep = (size_t)(BK * 2);
    const size_t hstep = (size_t)HALF * K * 2;
    const size_t tstep = 2 * hstep;
    const unsigned ldsw = (unsigned)wid * 1024u;
    const int aoff = lds_byte(wr * 64 + fr, fq * 8), boff = lds_byte(wc * 32 + fr, fq * 8);
#define PG8_SA(b, h) (((b) * 2 + (h)) * HTB)
#define PG8_SB(b, h) ((4 + (b) * 2 + (h)) * HTB)
#define PG8_STAGE(bufoff, gbase, voff) do { _Pragma("unroll") for (int _i = 0; _i < 2; ++_i) \
        __builtin_amdgcn_global_load_lds((const unsigned*)((const char*)(gbase) + (voff)[_i]), (PG8_LAS unsigned*)(lds + (bufoff) + ldsw + _i * 8192), 16, 0, 0); } while (0)
#define PG8_LDA(dst, b, h) do { _Pragma("unroll") for (int m = 0; m < 4; ++m) _Pragma("unroll") for (int k = 0; k < 2; ++k) dst[m][k] = *(const PG8_LAS bf16x8*)(lds + PG8_SA(b, h) + aoff + m * 2048 + k * 1024); } while (0)
#define PG8_LDB(dst, b, h) do { _Pragma("unroll") for (int n = 0; n < 2; ++n) _Pragma("unroll") for (int k = 0; k < 2; ++k) dst[n][k] = *(const PG8_LAS bf16x8*)(lds + PG8_SB(b, h) + boff + n * 2048 + k * 1024); } while (0)
#define PG8_MMA(ai, bj, At, Bt) do { __builtin_amdgcn_s_setprio(1); _Pragma("unroll") for (int m = 0; m < 4; ++m) _Pragma("unroll") for (int n = 0; n < 2; ++n) _Pragma("unroll") for (int k = 0; k < 2; ++k) \
        acc[ai][bj][m][n] = __builtin_amdgcn_mfma_f32_16x16x32_bf16(Bt[n][k], At[m][k], acc[ai][bj][m][n], 0, 0, 0); __builtin_amdgcn_s_setprio(0); } while (0)
#define PG8_WAIT_V(n) asm volatile("s_waitcnt vmcnt(" #n ")" ::: "memory")
#define PG8_WAIT_L(n) asm volatile("s_waitcnt lgkmcnt(" #n ")" ::: "memory")
#define PG8_BAR __builtin_amdgcn_s_barrier()
#define PG8_SCHED __builtin_amdgcn_sched_barrier(0)
    Unit cur, nxt; int ui = 0;
    if (!S.next(0, cur)) return;
    f32x4 acc[2][2][4][2];
#pragma unroll
    for (int a = 0; a < 2; ++a)
#pragma unroll
        for (int b = 0; b < 2; ++b)
#pragma unroll
            for (int m = 0; m < 4; ++m)
#pragma unroll
                for (int n = 0; n < 2; ++n) acc[a][b][m][n] = (f32x4){0.f, 0.f, 0.f, 0.f};
    bf16x8 At[4][2], B0[2][2], B1[2][2];
    const char* cA = (const char*)g.A + (size_t)cur.pm * tstep; const char* cB = (const char*)g.Bt + (size_t)cur.pn * tstep;
    S.a_ready(cur);
    if constexpr (SP2) {
        PG8_STAGE(PG8_SB(0, 0), cB, voffB); PG8_STAGE(PG8_SB(0, 1), cB + hstep, voffB); PG8_STAGE(PG8_SA(0, 0), cA, voffA); PG8_STAGE(PG8_SA(0, 1), cA + hstep, voffA);
        if (wr == 1) PG8_BAR;
        PG8_WAIT_V(2); PG8_BAR;
        PG8_STAGE(PG8_SB(1, 0), cB + kstep, voffB); PG8_STAGE(PG8_SA(1, 0), cA + kstep, voffA); PG8_STAGE(PG8_SB(1, 1), cB + hstep + kstep, voffB);
        PG8_WAIT_V(6); PG8_BAR;
    } else {
        PG8_STAGE(PG8_SB(0, 0), cB, voffB); PG8_STAGE(PG8_SA(0, 0), cA, voffA); PG8_STAGE(PG8_SB(0, 1), cB + hstep, voffB); PG8_STAGE(PG8_SA(0, 1), cA + hstep, voffA);
        if (wr == 1) PG8_BAR;
        PG8_WAIT_V(4); PG8_BAR;
        PG8_STAGE(PG8_SB(1, 0), cB + kstep, voffB); PG8_STAGE(PG8_SA(1, 0), cA + kstep, voffA); PG8_STAGE(PG8_SB(1, 1), cB + hstep + kstep, voffB);
        PG8_WAIT_V(6); PG8_BAR;
    }
    for (;;) {
        const bool has_next = S.next(ui + 1, nxt);
        const char* nA = has_next ? (const char*)g.A + (size_t)nxt.pm * tstep : cA; const char* nB = has_next ? (const char*)g.Bt + (size_t)nxt.pn * tstep : cB;
        for (int t = 0; t < nt; t += 2) {
            const bool last = (t == nt - 2);
            const char* a1 = cA + (size_t)(t + 1) * kstep;
            const char* a2 = last ? nA : cA + (size_t)(t + 2) * kstep; const char* b2 = last ? nB : cB + (size_t)(t + 2) * kstep;
            const char* a3 = a2 + kstep; const char* b3 = b2 + kstep;
            if (last && has_next) S.a_ready(nxt);
            if constexpr (SP2) {
            PG8_LDB(B0, 0, 0); PG8_LDB(B1, 0, 1); PG8_SCHED; PG8_LDA(At, 0, 0); PG8_STAGE(PG8_SA(1, 1), a1 + hstep, voffA);
            PG8_WAIT_V(8); PG8_WAIT_L(0); PG8_BAR; PG8_MMA(0, 0, At, B0); PG8_MMA(0, 1, At, B1); PG8_BAR; PG8_SCHED;
            PG8_LDA(At, 0, 1); PG8_STAGE(PG8_SB(0, 0), b2, voffB); PG8_STAGE(PG8_SB(0, 1), b2 + hstep, voffB); PG8_STAGE(PG8_SA(0, 0), a2, voffA);
            PG8_WAIT_V(8); PG8_WAIT_L(0); PG8_BAR; PG8_MMA(1, 0, At, B0); PG8_MMA(1, 1, At, B1); PG8_BAR; PG8_SCHED;
            PG8_LDB(B0, 1, 0); PG8_LDB(B1, 1, 1); PG8_SCHED; PG8_LDA(At, 1, 0); PG8_STAGE(PG8_SA(0, 1), a2 + hstep, voffA);
            PG8_WAIT_V(8); PG8_WAIT_L(0); PG8_BAR; PG8_MMA(0, 0, At, B0); PG8_MMA(0, 1, At, B1); PG8_BAR; PG8_SCHED;
            PG8_LDA(At, 1, 1); PG8_STAGE(PG8_SB(1, 0), b3, voffB); PG8_STAGE(PG8_SB(1, 1), b3 + hstep, voffB); PG8_STAGE(PG8_SA(1, 0), a3, voffA);
            PG8_WAIT_V(8); PG8_WAIT_L(0); PG8_BAR; PG8_MMA(1, 0, At, B0); PG8_MMA(1, 1, At, B1); PG8_BAR; PG8_SCHED;
            } else {
            PG8_LDB(B0, 0, 0); PG8_SCHED; PG8_LDA(At, 0, 0); PG8_STAGE(PG8_SA(1, 1), a1 + hstep, voffA);
            PG8_WAIT_L(8); PG8_BAR; PG8_WAIT_L(0); PG8_MMA(0, 0, At, B0); PG8_BAR; PG8_SCHED;
            PG8_LDB(B1, 0, 1); PG8_STAGE(PG8_SB(0, 0), b2, voffB);
            PG8_BAR; PG8_WAIT_L(0); PG8_MMA(0, 1, At, B1); PG8_BAR;
            PG8_LDA(At, 0, 1); PG8_STAGE(PG8_SA(0, 0), a2, voffA);
            PG8_BAR; PG8_WAIT_L(0); PG8_MMA(1, 0, At, B0); PG8_BAR; PG8_SCHED;
            PG8_STAGE(PG8_SB(0, 1), b2 + hstep, voffB);
            PG8_WAIT_V(6); PG8_BAR; PG8_MMA(1, 1, At, B1); PG8_BAR;
            PG8_LDB(B0, 1, 0); PG8_SCHED; PG8_LDA(At, 1, 0); PG8_STAGE(PG8_SA(0, 1), a2 + hstep, voffA);
            PG8_WAIT_L(8); PG8_BAR; PG8_WAIT_L(0); PG8_MMA(0, 0, At, B0); PG8_BAR; PG8_SCHED;
            PG8_LDB(B1, 1, 1); PG8_STAGE(PG8_SB(1, 0), b3, voffB);
            PG8_BAR; PG8_WAIT_L(0); PG8_MMA(0, 1, At, B1); PG8_BAR;
            PG8_LDA(At, 1, 1); PG8_STAGE(PG8_SA(1, 0), a3, voffA);
            PG8_BAR; PG8_WAIT_L(0); PG8_MMA(1, 0, At, B0); PG8_BAR; PG8_SCHED;
            PG8_STAGE(PG8_SB(1, 1), b3 + hstep, voffB);
            PG8_WAIT_V(6); PG8_BAR; PG8_MMA(1, 1, At, B1); PG8_BAR;
            }
        }
        if constexpr (ALIGN_EPI) { if (wr == 0) PG8_BAR; }
        if constexpr (!Epi::AFTER_DRAIN) { E(acc, cur, wr, wc, fr, fq); S.done(cur); }
        if (!has_next) break;
#pragma unroll
        for (int a = 0; a < 2; ++a)
#pragma unroll
            for (int b = 0; b < 2; ++b)
#pragma unroll
                for (int m = 0; m < 4; ++m)
#pragma unroll
                    for (int n = 0; n < 2; ++n) acc[a][b][m][n] = (f32x4){0.f, 0.f, 0.f, 0.f};
        cur = nxt; cA = nA; cB = nB; ++ui;
        if constexpr (ALIGN_EPI) { if (wr == 1) PG8_BAR; }
    }
    PG8_WAIT_V(0);
    if constexpr (!ALIGN_EPI) { if (wr == 0) PG8_BAR; }
    PG8_BAR;
    if constexpr (Epi::AFTER_DRAIN) { E.fused(acc, cur, wr, wc, fr, fq, lds, wid, lane); S.done(cur); }
#undef PG8_SA
#undef PG8_SB
#undef PG8_STAGE
#undef PG8_LDA
#undef PG8_LDB
#undef PG8_MMA
#undef PG8_WAIT_V
#undef PG8_WAIT_L
#undef PG8_BAR
#undef PG8_SCHED
}
}

constexpr int DM = 1024, NBATCH = 32, SEQ = 2048, NCTX = 256;
constexpr int ML = NBATCH * SEQ, MC = NBATCH * NCTX, MT = ML + MC;
constexpr int INW = 1536, DFF = 2816, NMOD = 6144;
constexpr float EPS = 1e-6f;
constexpr int NWAVES = 8;
#ifndef REP_P0
#define REP_P0 1
#endif
#ifndef REP_MIX
#define REP_MIX 1
#endif
#ifndef REP_NORM
#define REP_NORM 1
#endif
#ifndef REP_G3
#define REP_G3 1
#endif
#ifndef REP_G1
#define REP_G1 1
#endif
#ifndef MK_SPLIT
#define MK_SPLIT 0
#endif

constexpr size_t MiB = 1u << 20;
constexpr size_t WS_CTL = 0, CTL_ZERO_BYTES = 65536;
constexpr size_t WS_ROPE = 1 * MiB, WS_MOD = 2 * MiB, WS_AMOD = 4 * MiB, WS_WMODT = 8 * MiB, WS_WINT = 32 * MiB, WS_WOUTT = 38 * MiB, WS_WF1T = 42 * MiB, WS_WF2T = 64 * MiB;
constexpr size_t WS_XS = 80 * MiB, WS_H = 368 * MiB, WS_U = 512 * MiB, WS_CAT = 728 * MiB, WS_ACT = 512 * MiB, WS_END = 908 * MiB;
static_assert(WS_XS + (size_t)MT * DM * 4 <= WS_H && WS_H + (size_t)MT * DM * 2 <= WS_U && WS_U + (size_t)MT * INW * 2 <= WS_CAT && WS_CAT + (size_t)MT * DM * 2 <= WS_END && WS_ACT + (size_t)MT * DFF * 2 <= WS_END, "ws map");
static_assert(WS_WF2T + (size_t)2 * DM * DFF * 2 <= WS_XS && WS_WF1T + (size_t)2 * 2 * DFF * DM * 2 <= WS_WF2T && WS_WMODT + (size_t)2 * NMOD * DM * 2 <= WS_WINT, "ws map (weights)");

constexpr int RING_BYTES = 131072, LDS_BYTES = 147456;

#define LAS __attribute__((address_space(3)))
typedef unsigned short bf16;
typedef unsigned v4u __attribute__((ext_vector_type(4)));
typedef unsigned v2u __attribute__((ext_vector_type(2)));
typedef float f32x4 __attribute__((ext_vector_type(4)));
typedef float f32x16 __attribute__((ext_vector_type(16)));
typedef short bf16x8 __attribute__((ext_vector_type(8)));
typedef float f32x2_t __attribute__((ext_vector_type(2)));
typedef __bf16 bf16x2_t __attribute__((ext_vector_type(2)));
__device__ __forceinline__ unsigned pk2(float lo, float hi) { f32x2_t v = {lo, hi}; bf16x2_t b = __builtin_convertvector(v, bf16x2_t); return __builtin_bit_cast(unsigned, b); }
__device__ __forceinline__ float bflo(unsigned w) { return __uint_as_float(w << 16); }
__device__ __forceinline__ float bfhi(unsigned w) { return __uint_as_float(w & 0xffff0000u); }
__device__ __forceinline__ float wave_sum(float v) {
#pragma unroll
    for (int o = 1; o < 64; o <<= 1) v += __shfl_xor(v, o);
    return v;
}
__device__ __forceinline__ float silu_f(float v) { return v / (1.0f + __expf(-v)); }

struct Params {
    const float *x, *c, *ctx, *c_ctx, *w_mod, *b_mod, *n1g, *n2g, *w_in, *cdw, *cdwb, *clng, *clnb, *sink, *poolw, *pools, *w_out, *wf1, *wf2, *fing;
    float* out; unsigned char* ws;
    int ph_lo, ph_hi;
};

__device__ __forceinline__ void tr_item(const float* W, int ldw, bf16* WT, int ldt, int k0, int n0, int drow0, LAS float* scr, int lane) {
#pragma unroll 8
    for (int i = 0; i < 32; ++i) { const int kk = 2 * i + (lane >> 5); scr[kk * 33 + (lane & 31)] = W[(size_t)(k0 + kk) * ldw + n0 + (lane & 31)]; }
    asm volatile("s_waitcnt lgkmcnt(0)" ::: "memory");
    const int c = lane & 7;
#pragma unroll
    for (int j = 0; j < 4; ++j) { const int n = (lane >> 3) + 8 * j; const LAS float* s = scr + (8 * c) * 33 + n;
        v4u o; o.x = pk2(s[0 * 33], s[1 * 33]); o.y = pk2(s[2 * 33], s[3 * 33]); o.z = pk2(s[4 * 33], s[5 * 33]); o.w = pk2(s[6 * 33], s[7 * 33]);
        *(v4u*)(WT + (size_t)(drow0 + n) * ldt + k0 + 8 * c) = o; }
    asm volatile("s_waitcnt lgkmcnt(0)" ::: "memory");
}
__device__ __forceinline__ void fold_item(const float* wout, const float* pw, const float* ps, bf16* WoutT, int g, int nc, int lane) {
    const int n = nc * 64 + lane;
    float w[64];
#pragma unroll
    for (int d = 0; d < 64; ++d) w[d] = wout[(size_t)(768 + 64 * g + d) * 1024 + n] * ps[64 * g + d];
    const float* pg = pw + (size_t)g * 4096;
    for (int c8 = 0; c8 < 8; ++c8) {
        float a[8];
#pragma unroll
        for (int cc = 0; cc < 8; ++cc) { const float* pr = pg + (c8 * 8 + cc) * 64; float s = 0.f;
#pragma unroll
            for (int d = 0; d < 64; ++d) s = fmaf(pr[d], w[d], s);
            a[cc] = s; }
        v4u o; o.x = pk2(a[0], a[1]); o.y = pk2(a[2], a[3]); o.z = pk2(a[4], a[5]); o.w = pk2(a[6], a[7]);
        *(v4u*)(WoutT + (size_t)n * 1024 + 768 + 64 * g + c8 * 8) = o;
    }
}

__device__ __forceinline__ void phase_p0a(const Params& P, LAS unsigned char* lds, int G, int tid, int wave, int lane) {
    unsigned char* ws = P.ws;
    LAS float* scr = (LAS float*)(lds + wave * 16384);
    const int gw = blockIdx.x * NWAVES + wave, NGW = G * NWAVES;
    bf16* WmodT = (bf16*)(ws + WS_WMODT);
    for (int it = gw; it < 2 * 3072; it += NGW) { const int l = it / 3072, r = it % 3072, kb = r / 192, nb = r % 192;
        tr_item(P.w_mod + (size_t)l * 1024 * NMOD, NMOD, WmodT, 1024, 64 * kb, 32 * nb, l * NMOD + 32 * nb, scr, lane); }
    const int gt = blockIdx.x * 512 + tid, GT = G * 512;
    bf16* Amod = (bf16*)(ws + WS_AMOD);
    for (int i = gt; i < 256 * 128; i += GT) { const int row = i >> 7, c8 = (i & 127) * 8; v4u o = {0u, 0u, 0u, 0u};
        if (row < 33) { const float* s = (row < 32 ? P.c + (size_t)row * 1024 : P.c_ctx) + c8; const f32x4 a = *(const f32x4*)s, b = *(const f32x4*)(s + 4);
            o.x = pk2(silu_f(a[0]), silu_f(a[1])); o.y = pk2(silu_f(a[2]), silu_f(a[3])); o.z = pk2(silu_f(b[0]), silu_f(b[1])); o.w = pk2(silu_f(b[2]), silu_f(b[3])); }
        *(v4u*)(Amod + (size_t)row * 1024 + c8) = o; }
    float* rope = (float*)(ws + WS_ROPE);
    if (gt < 1024) { const int p = gt >> 4, i = gt & 15; const float inv = powf(10000.0f, -(float)(2 * i) / 32.0f); const float ang = (float)p * inv; float sn, cs; sincosf(ang, &sn, &cs); rope[gt] = cs; rope[1024 + gt] = sn; }
}
__device__ __forceinline__ void phase_p0b_convert(const Params& P, LAS unsigned char* lds, int G, int wave, int lane) {
    unsigned char* ws = P.ws;
    LAS float* scr = (LAS float*)(lds + wave * 16384);
    const int gw = ((int)blockIdx.x - 48) * NWAVES + wave, NGW = (G - 48) * NWAVES;
    constexpr int I_IN = 16 * 48, I_OUT = 12 * 32, I_F1 = 16 * 176, I_F2 = 44 * 32, I_FOLD = 64, I_L = I_IN + I_OUT + I_F1 + I_F2 + I_FOLD;
    for (int it = gw; it < 2 * I_L; it += NGW) {
        const int l = it / I_L; int r = it % I_L;
        if (r < I_FOLD) { fold_item(P.w_out + (size_t)l * 1024 * 1024, P.poolw + (size_t)l * 4 * 4096, P.pools + l * 256, (bf16*)(ws + WS_WOUTT) + (size_t)l * 1024 * 1024, r >> 4, r & 15, lane); continue; } r -= I_FOLD;
        if (r < I_IN) { const int kb = r / 48, nb = r % 48; tr_item(P.w_in + (size_t)l * 1024 * INW, INW, (bf16*)(ws + WS_WINT) + (size_t)l * INW * 1024, 1024, 64 * kb, 32 * nb, 32 * nb, scr, lane); continue; } r -= I_IN;
        if (r < I_OUT) { const int kb = r / 32, nb = r % 32; tr_item(P.w_out + (size_t)l * 1024 * 1024, 1024, (bf16*)(ws + WS_WOUTT) + (size_t)l * 1024 * 1024, 1024, 64 * kb, 32 * nb, 32 * nb, scr, lane); continue; } r -= I_OUT;
        if (r < I_F1) { const int kb = r / 176, nb = r % 176; const int n0 = 32 * nb; const int isu = n0 >= DFF; const int nn = n0 - isu * DFF; const int drow = 256 * (nn / 128) + 128 * isu + (nn % 128);
            tr_item(P.wf1 + (size_t)l * 1024 * 2 * DFF, 2 * DFF, (bf16*)(ws + WS_WF1T) + (size_t)l * 2 * DFF * 1024, 1024, 64 * kb, n0, drow, scr, lane); continue; } r -= I_F1;
        { const int kb = r / 32, nb = r % 32; tr_item(P.wf2 + (size_t)l * DFF * 1024, 1024, (bf16*)(ws + WS_WF2T) + (size_t)l * 1024 * DFF, DFF, 64 * kb, 32 * nb, 32 * nb, scr, lane); }
    }
}

__device__ __forceinline__ void phase_norm(const float* srcL, const float* srcC, bf16* H, const float* gvec, const float* mod_sh, const float* mod_sc, int nrows, int G, int wave, int lane) {
    const int gw = blockIdx.x * NWAVES + wave, NGW = G * NWAVES;
    for (int row = gw; row < nrows; row += NGW) {
        const bool latent = row < ML; const int mrow = latent ? (row >> 11) : 32;
        const f32x4* xr = (const f32x4*)(latent ? srcL + (size_t)row * DM : srcC + (size_t)(row - ML) * DM) + lane;
        f32x4 v[4]; float s = 0.f;
#pragma unroll
        for (int j = 0; j < 4; ++j) { v[j] = xr[64 * j]; s += (v[j].x * v[j].x + v[j].y * v[j].y) + (v[j].z * v[j].z + v[j].w * v[j].w); }
        const float rstd = rsqrtf(wave_sum(s) * (1.f / DM) + EPS);
        v2u* o8 = (v2u*)(H + (size_t)row * DM) + lane;
#pragma unroll
        for (int j = 0; j < 4; ++j) { const int col = 4 * (lane + 64 * j);
            const f32x4 g = *(const f32x4*)(gvec + col), sc = *(const f32x4*)(mod_sc + (size_t)mrow * 12288 + col), sh = *(const f32x4*)(mod_sh + (size_t)mrow * 12288 + col);
            const f32x4 y = (v[j] * rstd) * g * (sc + 1.0f) + sh;
            v2u o; o.x = pk2(y.x, y.y); o.y = pk2(y.z, y.w); o8[64 * j] = o; }
    }
}
__device__ __forceinline__ void phase_final(const float* src, float* out, const float* gvec, int G, int wave, int lane) {
    const int gw = blockIdx.x * NWAVES + wave, NGW = G * NWAVES;
    for (int row = gw; row < ML; row += NGW) {
        const f32x4* xr = (const f32x4*)(src + (size_t)row * DM) + lane;
        f32x4 v[4]; float s = 0.f;
#pragma unroll
        for (int j = 0; j < 4; ++j) { v[j] = xr[64 * j]; s += (v[j].x * v[j].x + v[j].y * v[j].y) + (v[j].z * v[j].z + v[j].w * v[j].w); }
        const float rstd = rsqrtf(wave_sum(s) * (1.f / DM) + EPS);
        f32x4* o = (f32x4*)(out + (size_t)row * DM) + lane;
#pragma unroll
        for (int j = 0; j < 4; ++j) { const f32x4 g = *(const f32x4*)(gvec + 4 * (lane + 64 * j)); o[64 * j] = (v[j] * rstd) * g; }
    }
}

constexpr int KV_STRIDE = 144;
constexpr int KV_TILE = 64 * KV_STRIDE;
#define MFMA32(a, b, c) __builtin_amdgcn_mfma_f32_32x32x16_bf16((a), (b), (c), 0, 0, 0)
__device__ __forceinline__ int crow(int r, int h) { return (r & 3) + 8 * (r >> 2) + 4 * h; }
__device__ __forceinline__ void attn_unit(LAS unsigned char* lds, const bf16* U, bf16* CAT, const float* sinkp, int unit, int tid, int wave, int lane) {
    const int r32 = lane & 31, h = lane >> 5;
    int b, kvh, p0, qrow0; bool is_lat;
    if (unit < 2048) { b = unit >> 6; kvh = (unit >> 5) & 1; p0 = (unit & 31) * 64; qrow0 = b * SEQ + p0; is_lat = true; }
    else { const int cu = unit - 2048; b = cu >> 3; kvh = (cu >> 2) & 1; p0 = 0; qrow0 = ML + b * NCTX + (cu & 3) * 64; is_lat = false; }
    const int ctxrow0 = ML + b * NCTX;
    int lt_lo = 0, nt = 4;
    if (is_lat) { lt_lo = (p0 >= 128) ? 0 : (p0 >= 64 ? 1 : 2); const int lt_hi = (p0 + 192 <= SEQ) ? 4 : ((p0 + 128 <= SEQ) ? 3 : 2); nt = 4 + lt_hi - lt_lo + 1; }
    const int head = kvh * 4 + (wave >> 1), qi = 32 * (wave & 1) + r32;
    bf16x8 qf[4];
    { const bf16* qp = U + (size_t)(qrow0 + qi) * INW + head * 64 + 8 * h;
#pragma unroll
      for (int d0 = 0; d0 < 4; ++d0) qf[d0] = *(const bf16x8*)(qp + 16 * d0); }
    float m_run = sinkp[head] * 1.4426950408889634f, l_run = (h == 0) ? 1.f : 0.f;
    f32x16 o0, o1;
#pragma unroll
    for (int r = 0; r < 16; ++r) { o0[r] = 0.f; o1[r] = 0.f; }
    const int kkey = tid >> 3, kch = tid & 7;
    const int vkey = tid & 63, vch = tid >> 6;
    const int vslot = (vkey & ~15) + 8 * ((vkey >> 2) & 1) + 4 * ((vkey >> 3) & 1) + (vkey & 3);
    LAS unsigned char* Kb = lds; LAS unsigned char* Vb = lds + 2 * KV_TILE;
    const size_t kcol = 512 + kvh * 64 + kch * 8, vcol = 640 + kvh * 64 + vch * 8;
    v4u kreg, vreg;
#define TILE_ROW(t) ((t) < 4 ? ctxrow0 + 64 * (t) : b * SEQ + p0 - 128 + 64 * (lt_lo + (t) - 4))
#define LOAD_TILE(t) do { const int rb_ = TILE_ROW(t); kreg = *(const v4u*)(U + (size_t)(rb_ + kkey) * INW + kcol); vreg = *(const v4u*)(U + (size_t)(rb_ + vkey) * INW + vcol); } while (0)
#define STORE_TILE(buf) do { *(LAS v4u*)(Kb + (buf) * KV_TILE + kkey * KV_STRIDE + kch * 16) = kreg; \
        LAS unsigned short* vp_ = (LAS unsigned short*)(Vb + (buf) * KV_TILE + (vch * 8) * KV_STRIDE + vslot * 2); \
        vp_[0 * (KV_STRIDE / 2)] = (unsigned short)(vreg.x & 0xffffu); vp_[1 * (KV_STRIDE / 2)] = (unsigned short)(vreg.x >> 16); \
        vp_[2 * (KV_STRIDE / 2)] = (unsigned short)(vreg.y & 0xffffu); vp_[3 * (KV_STRIDE / 2)] = (unsigned short)(vreg.y >> 16); \
        vp_[4 * (KV_STRIDE / 2)] = (unsigned short)(vreg.z & 0xffffu); vp_[5 * (KV_STRIDE / 2)] = (unsigned short)(vreg.z >> 16); \
        vp_[6 * (KV_STRIDE / 2)] = (unsigned short)(vreg.w & 0xffffu); vp_[7 * (KV_STRIDE / 2)] = (unsigned short)(vreg.w >> 16); } while (0)
    __syncthreads();
    LOAD_TILE(0); STORE_TILE(0);
    __syncthreads();
    for (int t = 0; t < nt; ++t) {
        const int buf = t & 1;
        if (t + 1 < nt) LOAD_TILE(t + 1);
        const LAS unsigned char* kb = Kb + buf * KV_TILE + r32 * KV_STRIDE + 16 * h;
        const LAS unsigned char* vb = Vb + buf * KV_TILE + r32 * KV_STRIDE + 16 * h;
        f32x16 s0, s1;
#pragma unroll
        for (int r = 0; r < 16; ++r) { s0[r] = 0.f; s1[r] = 0.f; }
#pragma unroll
        for (int d0 = 0; d0 < 4; ++d0) {
            const bf16x8 k0 = *(const LAS bf16x8*)(kb + 32 * d0), k1 = *(const LAS bf16x8*)(kb + 32 * KV_STRIDE + 32 * d0);
            s0 = MFMA32(k0, qf[d0], s0); s1 = MFMA32(k1, qf[d0], s1);
        }
        int mtype = 0;
        if (t >= 4) { const int lt = lt_lo + t - 4; mtype = (lt == 0) ? 1 : ((lt == 4) ? 2 : 0); }
        if (mtype) {
#pragma unroll
            for (int r = 0; r < 16; ++r) { const int k0 = crow(r, h), k1 = 32 + k0;
                const bool v0 = (mtype == 1) ? (k0 >= qi) : (k0 <= qi), v1 = (mtype == 1) ? (k1 >= qi) : (k1 <= qi);
                if (!v0) s0[r] = -1e30f; if (!v1) s1[r] = -1e30f; }
        }
        float mx = s0[0];
#pragma unroll
        for (int r = 1; r < 16; ++r) mx = fmaxf(mx, s0[r]);
#pragma unroll
        for (int r = 0; r < 16; ++r) mx = fmaxf(mx, s1[r]);
        mx = fmaxf(mx, __shfl_xor(mx, 32));
        const float m_new = fmaxf(m_run, mx), alpha = __builtin_amdgcn_exp2f(m_run - m_new);
        m_run = m_new;
        float ps = 0.f;
#pragma unroll
        for (int r = 0; r < 16; ++r) { s0[r] = __builtin_amdgcn_exp2f(s0[r] - m_new); s1[r] = __builtin_amdgcn_exp2f(s1[r] - m_new); ps += s0[r] + s1[r]; }
        l_run = l_run * alpha + ps;
#pragma unroll
        for (int r = 0; r < 16; ++r) { o0[r] *= alpha; o1[r] *= alpha; }
        v4u pf[4];
        pf[0] = (v4u){pk2(s0[0], s0[1]), pk2(s0[2], s0[3]), pk2(s0[4], s0[5]), pk2(s0[6], s0[7])};
        pf[1] = (v4u){pk2(s0[8], s0[9]), pk2(s0[10], s0[11]), pk2(s0[12], s0[13]), pk2(s0[14], s0[15])};
        pf[2] = (v4u){pk2(s1[0], s1[1]), pk2(s1[2], s1[3]), pk2(s1[4], s1[5]), pk2(s1[6], s1[7])};
        pf[3] = (v4u){pk2(s1[8], s1[9]), pk2(s1[10], s1[11]), pk2(s1[12], s1[13]), pk2(s1[14], s1[15])};
#pragma unroll
        for (int s4 = 0; s4 < 4; ++s4) {
            const bf16x8 v0 = *(const LAS bf16x8*)(vb + 32 * s4), v1 = *(const LAS bf16x8*)(vb + 32 * KV_STRIDE + 32 * s4);
            o0 = MFMA32(v0, __builtin_bit_cast(bf16x8, pf[s4]), o0); o1 = MFMA32(v1, __builtin_bit_cast(bf16x8, pf[s4]), o1);
        }
        if (t + 1 < nt) STORE_TILE(buf ^ 1);
        __syncthreads();
    }
#undef TILE_ROW
#undef LOAD_TILE
#undef STORE_TILE
    const float lt = l_run + __shfl_xor(l_run, 32), inv = 1.0f / lt;
    bf16* op = CAT + (size_t)(qrow0 + qi) * DM + head * 64 + 4 * h;
#pragma unroll
    for (int g4 = 0; g4 < 4; ++g4) {
        v2u w0, w1;
        w0.x = pk2(o0[4 * g4] * inv, o0[4 * g4 + 1] * inv); w0.y = pk2(o0[4 * g4 + 2] * inv, o0[4 * g4 + 3] * inv);
        w1.x = pk2(o1[4 * g4] * inv, o1[4 * g4 + 1] * inv); w1.y = pk2(o1[4 * g4 + 2] * inv, o1[4 * g4 + 3] * inv);
        *(v2u*)(op + 8 * g4) = w0; *(v2u*)(op + 32 + 8 * g4) = w1;
    }
}

__device__ __forceinline__ void convpool_unit(LAS unsigned char* lds, const bf16* U, bf16* CAT, const float* dw, const float* dwb, const float* lng, const float* lnb, int cv, int tid, int wave, int lane) {
    const int row0 = cv * 32; const bool latent = row0 < ML;
    const int seq0 = latent ? (row0 & ~(SEQ - 1)) : ML + ((row0 - ML) & ~(NCTX - 1)); const int slen = latent ? SEQ : NCTX;
    LAS float* hbuf = (LAS float*)lds;
    LAS float* cbuf = (LAS float*)(lds + 62 * 256 * 4);
    __syncthreads();
    { const int ch = tid & 31;
#pragma unroll
      for (int pss = 0; pss < 4; ++pss) { const int rr = pss * 16 + (tid >> 5); if (rr < 62) { const int grow = row0 - 15 + rr;
          f32x4 h0 = {0.f, 0.f, 0.f, 0.f}, h1 = h0;
          if (grow >= seq0 && grow < seq0 + slen) { const bf16* up = U + (size_t)grow * INW + 768 + 8 * ch; const v4u a = *(const v4u*)up, g = *(const v4u*)(up + 256);
#define GLU(A, Gv) ((A) / (1.0f + __expf(-(Gv))))
              h0[0] = GLU(bflo(a.x), bflo(g.x)); h0[1] = GLU(bfhi(a.x), bfhi(g.x)); h0[2] = GLU(bflo(a.y), bflo(g.y)); h0[3] = GLU(bfhi(a.y), bfhi(g.y));
              h1[0] = GLU(bflo(a.z), bflo(g.z)); h1[1] = GLU(bfhi(a.z), bfhi(g.z)); h1[2] = GLU(bflo(a.w), bflo(g.w)); h1[3] = GLU(bfhi(a.w), bfhi(g.w));
#undef GLU
          }
          *(LAS f32x4*)(hbuf + rr * 256 + 8 * ch) = h0; *(LAS f32x4*)(hbuf + rr * 256 + 8 * ch + 4) = h1; } } }
    __syncthreads();
    { const int c = tid & 255, half = tid >> 8;
      float hv[46];
#pragma unroll
      for (int i = 0; i < 46; ++i) hv[i] = hbuf[(half * 16 + i) * 256 + c];
      float acc[16]; const float bias = dwb[c];
#pragma unroll
      for (int o = 0; o < 16; ++o) acc[o] = bias;
#pragma unroll
      for (int j = 0; j < 31; ++j) { const float w = dw[j * 256 + c];
#pragma unroll
          for (int o = 0; o < 16; ++o) acc[o] = fmaf(w, hv[o + j], acc[o]); }
#pragma unroll
      for (int o = 0; o < 16; ++o) cbuf[(half * 16 + o) * 256 + c] = acc[o]; }
    __syncthreads();
    { const f32x4 g = *(const f32x4*)(lng + 4 * lane), bb = *(const f32x4*)(lnb + 4 * lane);
#pragma unroll
      for (int i = 0; i < 4; ++i) { const int r = wave * 4 + i; const f32x4 v = *(const LAS f32x4*)(cbuf + r * 256 + 4 * lane);
          const float mu = wave_sum((v.x + v.y) + (v.z + v.w)) * (1.f / 256.f); const f32x4 d = v - mu;
          const float var = wave_sum((d.x * d.x + d.y * d.y) + (d.z * d.z + d.w * d.w)) * (1.f / 256.f);
          const f32x4 hn = d * rsqrtf(var + EPS) * g + bb;
          v2u o; o.x = pk2(silu_f(hn.x), silu_f(hn.y)); o.y = pk2(silu_f(hn.z), silu_f(hn.w));
          *(v2u*)(CAT + (size_t)(row0 + r) * DM + 512 + 4 * lane) = o; } }
    { const int ch = tid & 31, gi = ch >> 3, win = 2 << gi;
#pragma unroll
      for (int pss = 0; pss < 2; ++pss) { const int row = row0 + pss * 16 + (tid >> 5); const int t = row - seq0;
          int lo = t - (win >> 1); lo = lo < 0 ? 0 : lo; int hi = t + win - 1 - (win >> 1); hi = hi > slen - 1 ? slen - 1 : hi;
          float s[8];
#pragma unroll
          for (int e = 0; e < 8; ++e) s[e] = 0.f;
          const bf16* up = U + (size_t)seq0 * INW + 1280 + 8 * ch;
          for (int r = lo; r <= hi; ++r) { const v4u a = *(const v4u*)(up + (size_t)r * INW);
              s[0] += bflo(a.x); s[1] += bfhi(a.x); s[2] += bflo(a.y); s[3] += bfhi(a.y); s[4] += bflo(a.z); s[5] += bfhi(a.z); s[6] += bflo(a.w); s[7] += bfhi(a.w); }
          const float rc = 1.0f / (float)(hi - lo + 1);
          const v4u x = *(const v4u*)(up + (size_t)t * INW);
          v4u o; o.x = pk2(s[0] * rc - bflo(x.x), s[1] * rc - bfhi(x.x)); o.y = pk2(s[2] * rc - bflo(x.y), s[3] * rc - bfhi(x.y));
          o.z = pk2(s[4] * rc - bflo(x.z), s[5] * rc - bfhi(x.z)); o.w = pk2(s[6] * rc - bflo(x.w), s[7] * rc - bfhi(x.w));
          *(v4u*)(CAT + (size_t)row * DM + 768 + 8 * ch) = o; } }
}

#define RLX_AGENT __ATOMIC_RELAXED, __HIP_MEMORY_SCOPE_AGENT
#define XB_TMO      128
#define XB_XCNT(j)  (256  + 64 * (j))
#define XB_XSUB(j)  (1280 + 64 * (j))
#define XB_XGEN(j)  (2304 + 64 * (j))
#define XB_TOP      3328
#define XB_TOPGEN   3392
#define XCD_BAR_WORDS 3456
#define XB_SPIN_CAP (1u << 18)

__device__ __forceinline__ unsigned xb_ld(unsigned* p)              { return __hip_atomic_load(p, __ATOMIC_RELAXED, __HIP_MEMORY_SCOPE_AGENT); }
__device__ __forceinline__ unsigned xb_add(unsigned* p, unsigned v) { return __hip_atomic_fetch_add(p, v, __ATOMIC_RELAXED, __HIP_MEMORY_SCOPE_AGENT); }
__device__ __forceinline__ unsigned xb_xcc_id() { return (unsigned)__builtin_amdgcn_s_getreg((3 << 11) | 20) & 0xFu; }
#define XB_SPIN(cond, bar) do { unsigned _sp = 0; while (cond) { __builtin_amdgcn_s_sleep(1); \
    if ((++_sp & 255u) == 0u) { if (xb_ld(&(bar)[XB_TMO])) break; if (_sp > XB_SPIN_CAP) { atomicAdd(&(bar)[XB_TMO], 1u); break; } } } } while (0)

struct XcdBarrier {
    unsigned* bar; unsigned x;
    volatile LAS unsigned* st;
};

__device__ __forceinline__ XcdBarrier xcd_barrier_post(unsigned* bar, volatile LAS unsigned* st) {
    XcdBarrier b; b.bar = bar; b.x = xb_xcc_id(); b.st = st;
    if (threadIdx.x == 0) (void)xb_add(&bar[XB_XCNT(b.x)], 1u);
    return b;
}
__device__ __forceinline__ void xcd_barrier_complete(unsigned* bar, unsigned x, unsigned& nloc, unsigned& nx) {
    const unsigned G = gridDim.x * gridDim.y * gridDim.z;
    unsigned sum, cnt, mine, sp = 0u;
    for (;;) {
        sum = 0u; cnt = 0u; mine = 0u;
#pragma unroll
        for (unsigned j = 0; j < 16; ++j) { const unsigned c = xb_ld(&bar[XB_XCNT(j)]); sum += c; cnt += (c > 0u) ? 1u : 0u; mine = (j == x) ? c : mine; }
        if (sum == G) break;
        __builtin_amdgcn_s_sleep(1);
        if ((++sp & 255u) == 0u) { if (xb_ld(&bar[XB_TMO])) break; if (sp > XB_SPIN_CAP) { atomicAdd(&bar[XB_TMO], 1u); break; } }
    }
    nloc = mine > 0u ? mine : 1u; nx = cnt > 0u ? cnt : 1u;
}

__device__ __forceinline__ void xcd_barrier(const XcdBarrier& b) {
    asm volatile("s_waitcnt vmcnt(0)" ::: "memory");
    __syncthreads();
    if (threadIdx.x == 0) {
        unsigned* bar = b.bar;
        __builtin_amdgcn_s_waitcnt(0);
        unsigned nloc = b.st[0], nx = b.st[1];
        if (nloc == 0u) { xcd_barrier_complete(bar, b.x, nloc, nx); b.st[0] = nloc; b.st[1] = nx; }
        const unsigned old = xb_add(&bar[XB_XSUB(b.x)], 1u);
        const unsigned gen = old / nloc;
        if (old + 1u == (gen + 1u) * nloc) {
            __builtin_amdgcn_fence(__ATOMIC_RELEASE, "agent");
            asm volatile("s_waitcnt vmcnt(0)" ::: "memory");
            const unsigned og = xb_add(&bar[XB_TOP], 1u);
            const unsigned tg = og / nx;
            if (og + 1u == (tg + 1u) * nx) xb_add(&bar[XB_TOPGEN], 1u);
            else XB_SPIN(xb_ld(&bar[XB_TOPGEN]) == tg, bar);
            __builtin_amdgcn_fence(__ATOMIC_ACQUIRE, "agent");
            xb_add(&bar[XB_XGEN(b.x)], 1u);
            asm volatile("s_waitcnt vmcnt(0)" ::: "memory");
        } else {
            XB_SPIN(xb_ld(&bar[XB_XGEN(b.x)]) == gen, bar);
            __builtin_amdgcn_fence(__ATOMIC_ACQUIRE, "agent");
            asm volatile("s_waitcnt vmcnt(0)" ::: "memory");
        }
    }
    __syncthreads();
}

__global__ void __launch_bounds__(NWAVES * 64, 2) fwd_megakernel(Params P) {
    extern __shared__ __attribute__((aligned(16))) unsigned char lds_raw[];
    LAS unsigned char* lds = (LAS unsigned char*)lds_raw;
    cg::grid_group grid = cg::this_grid();
    volatile LAS unsigned* MISC = (volatile LAS unsigned*)(lds + RING_BYTES);
    if (threadIdx.x < 64) MISC[threadIdx.x] = 0u;
    __syncthreads();
    XcdBarrier bar = xcd_barrier_post((unsigned*)(P.ws + WS_CTL), MISC + 8);
    const int G = gridDim.x;
#define FRESH_TID() int tid = threadIdx.x; asm volatile("" : "+v"(tid)); const int lane = tid & 63, wave = __builtin_amdgcn_readfirstlane(tid >> 6); (void)lane; (void)wave
    unsigned char* ws = P.ws;
    float* rope = (float*)(ws + WS_ROPE); float* modb = (float*)(ws + WS_MOD);
    bf16* Amod = (bf16*)(ws + WS_AMOD); bf16* WmodT = (bf16*)(ws + WS_WMODT);
    float* XS = (float*)(ws + WS_XS); bf16* H = (bf16*)(ws + WS_H); bf16* U = (bf16*)(ws + WS_U); bf16* CAT = (bf16*)(ws + WS_CAT); bf16* ACT = (bf16*)(ws + WS_ACT);
    const int lo = P.ph_lo, hi = P.ph_hi;
    int ph = 0;
#define IN_PH() (lo <= ph && ph < hi)
#define SEAM() do { if (!MK_SPLIT) { if (ph == 0) grid.sync(); else xcd_barrier(bar); } ++ph; } while (0)

    if (IN_PH()) for (int rep = 0; rep < REP_P0; ++rep) { FRESH_TID(); phase_p0a(P, lds, G, tid, wave, lane); }
    SEAM();
    if (IN_PH()) for (int rep = 0; rep < REP_P0; ++rep) {
        if (blockIdx.x < 48) { pg8::Gemm g{Amod, WmodT, 256, 2 * NMOD, DM}; pg8::SchedMod S{(int)blockIdx.x}; pg8::EpiMod E{modb, P.b_mod};
            pg8::gemm_phase<pg8::EpiMod, pg8::SchedMod, false, true>(lds, g, S, E); }
        else { FRESH_TID(); phase_p0b_convert(P, lds, G, wave, lane); }
    }
    SEAM();
#pragma unroll 1
    for (int l = 0; l < 2; ++l) {
        const bool last = (l == 1);
        const float* mod_l = modb + l * NMOD;
        const float* srcL = (l == 0) ? P.x : XS; const float* srcC = (l == 0) ? P.ctx : XS + (size_t)ML * DM;
        const int Mff = last ? ML : MT;
        if (IN_PH()) for (int rep = 0; rep < REP_NORM; ++rep) { FRESH_TID(); phase_norm(srcL, srcC, H, P.n1g + l * DM, mod_l + 0 * 1024, mod_l + 1 * 1024, MT, G, wave, lane); }
        SEAM();
        if (IN_PH()) for (int rep = 0; rep < REP_G1; ++rep) { pg8::Gemm g{H, (const bf16*)(ws + WS_WINT) + (size_t)l * INW * DM, MT, INW, DM}; pg8::StaticOrder S; S.init(MT, INW, G, (int)blockIdx.x); pg8::EpiInProj E{U, rope};
            pg8::gemm_phase<pg8::EpiInProj, pg8::StaticOrder, true, true>(lds, g, S, E); }
        SEAM();
        if (IN_PH()) for (int rep = 0; rep < REP_MIX; ++rep) {
            FRESH_TID(); const int NA = last ? 2048 : 2304, NCV = last ? (ML / 32) : (MT / 32);
            for (int u = blockIdx.x; u < NA; u += G) attn_unit(lds, U, CAT, P.sink + l * 8, u, tid, wave, lane);
            for (int u = blockIdx.x; u < NCV; u += G) convpool_unit(lds, U, CAT, P.cdw + l * 31 * 256, P.cdwb + l * 256, P.clng + l * 256, P.clnb + l * 256, u, tid, wave, lane);
        }
        SEAM();
        if (IN_PH()) { pg8::Gemm g{CAT, (const bf16*)(ws + WS_WOUTT) + (size_t)l * DM * DM, Mff, DM, DM}; pg8::StaticOrder S; S.init(Mff, DM, G, (int)blockIdx.x); pg8::EpiResid E{srcL, srcC, XS, mod_l + 2 * 1024};
            pg8::gemm_phase<pg8::EpiResid, pg8::StaticOrder, true, true>(lds, g, S, E); }
        SEAM();
        if (IN_PH()) for (int rep = 0; rep < REP_NORM; ++rep) { FRESH_TID(); phase_norm(XS, XS + (size_t)ML * DM, H, P.n2g + l * DM, mod_l + 3 * 1024, mod_l + 4 * 1024, Mff, G, wave, lane); }
        SEAM();
        if (IN_PH()) for (int rep = 0; rep < REP_G3; ++rep) { pg8::Gemm g{H, (const bf16*)(ws + WS_WF1T) + (size_t)l * 2 * DFF * DM, Mff, 2 * DFF, DM}; pg8::StaticOrder S; S.init(Mff, 2 * DFF, G, (int)blockIdx.x); pg8::EpiSwiGLU E{ACT};
            pg8::gemm_phase<pg8::EpiSwiGLU, pg8::StaticOrder, true, true>(lds, g, S, E); }
        SEAM();
        if (IN_PH()) { pg8::Gemm g{ACT, (const bf16*)(ws + WS_WF2T) + (size_t)l * DM * DFF, Mff, DM, DFF}; pg8::StaticOrder S; S.init(Mff, DM, G, (int)blockIdx.x); pg8::EpiResid E{XS, XS + (size_t)ML * DM, XS, mod_l + 5 * 1024};
            pg8::gemm_phase<pg8::EpiResid, pg8::StaticOrder, true, true>(lds, g, S, E); }
        SEAM();
    }
    if (IN_PH()) for (int rep = 0; rep < REP_NORM; ++rep) { FRESH_TID(); phase_final(XS, P.out, P.fing, G, wave, lane); }
#undef IN_PH
#undef SEAM
}
constexpr int N_PHASES = 2 + 2 * 7 + 1;

extern "C" void kernel_launch(void* const* d_in, const int* in_sizes, int n_in, void* d_out, int out_size, void* d_ws, size_t ws_size, hipStream_t stream) {
    static int grid = 0;
    if (grid == 0) {
        if (n_in != 20 || ws_size < WS_END) { fprintf(stderr, "kernel_launch: unexpected n_in %d or ws_size %zu (need %zu)\n", n_in, ws_size, (size_t)WS_END); grid = -1; return; }
        int dev = 0, cus = 0, per_cu = 0;
        hipGetDevice(&dev); hipDeviceGetAttribute(&cus, hipDeviceAttributeMultiprocessorCount, dev);
        if (hipFuncSetAttribute((const void*)fwd_megakernel, hipFuncAttributeMaxDynamicSharedMemorySize, LDS_BYTES) != hipSuccess) { fprintf(stderr, "kernel_launch: hipFuncSetAttribute failed\n"); grid = -1; return; }
        if (hipOccupancyMaxActiveBlocksPerMultiprocessor(&per_cu, (const void*)fwd_megakernel, NWAVES * 64, LDS_BYTES) != hipSuccess || per_cu < 1) { fprintf(stderr, "kernel_launch: occupancy query says %d\n", per_cu); per_cu = 1; }
        (void)hipGetLastError();
        grid = cus * per_cu;
        if (grid > 256) grid = 256;
        fprintf(stderr, "kernel_launch: grid %d (cus %d, per_cu %d)\n", grid, cus, per_cu);
    }
    if (grid < 0) return;
    if (hipMemsetAsync((char*)d_ws + WS_CTL, 0, CTL_ZERO_BYTES, stream) != hipSuccess) { fprintf(stderr, "kernel_launch: memset failed\n"); return; }
    Params p{};
    const float** pp = (const float**)&p;
    for (int i = 0; i < 20; ++i) pp[i] = (const float*)d_in[i];
    p.out = (float*)d_out; p.ws = (unsigned char*)d_ws;
#if MK_SPLIT
    for (int k = 0; k < N_PHASES; ++k) { p.ph_lo = k; p.ph_hi = k + 1; hipLaunchKernelGGL(fwd_megakernel, dim3(grid), dim3(NWAVES * 64), LDS_BYTES, stream, p); }
#else
    p.ph_lo = 0; p.ph_hi = N_PHASES;
    void* args[] = {&p};
    hipError_t e = hipLaunchCooperativeKernel((const void*)fwd_megakernel, dim3(grid), dim3(NWAVES * 64), args, LDS_BYTES, stream);
    if (e != hipSuccess) fprintf(stderr, "kernel_launch: cooperative launch failed: %s (grid %d)\n", hipGetErrorString(e), grid);
#endif
}
```

```cpp
#include <hip/hip_runtime.h>
#include <hip/hip_cooperative_groups.h>
#include <cstdio>
#include <cstdint>
namespace cg = cooperative_groups;
namespace pg8 {
#define PG8_LAS __attribute__((address_space(3)))
typedef unsigned short bf16_t;
typedef short bf16x8 __attribute__((ext_vector_type(8)));
typedef float f32x4 __attribute__((ext_vector_type(4)));
typedef unsigned u32x4 __attribute__((ext_vector_type(4)));
constexpr int BM = 256, BK = 64, HALF = 128, HTB = HALF * BK * 2  , STAGE_BYTES = 8 * HTB, NXCD = 8, WGM = 4;

__host__ __device__ __forceinline__ int lds_byte(int r, int c) { const int st = (r >> 4) * 2 + (c >> 5), rr = r & 15, cc = c & 31, ob = rr * 64 + cc * 2; return st * 1024 + (ob ^ (((ob >> 9) & 1) << 5)); }
__host__ __device__ __forceinline__ void stage_rc(int b, int& R, int& C) { const int st = b / 1024, sb = b % 1024, swz = sb ^ (((sb >> 9) & 1) << 5); R = (st >> 1) * 16 + swz / 64; C = (st & 1) * 32 + (swz % 64) / 2; }
__host__ __device__ __forceinline__ int perm32(int rho) { const int n = rho >> 4, i = rho & 15; return 8 * (i >> 2) + 4 * n + (i & 3); }

struct Unit { int pm, pn; };
struct Gemm { const bf16_t* A; const bf16_t* Bt; int M, N, K; };

struct StaticOrder {
    int nM, nN, nwg, G, c;
    __host__ __device__ void init(int M, int N, int G_, int c_) { nM = M / BM; nN = N / BM; nwg = nM * nN; G = G_; c = c_; }
    __host__ __device__ bool next(int i, Unit& u) const {
        const long L = (long)i * G + c; if (L >= nwg) return false;
        int wgid = (int)L; { const int q = nwg / NXCD, r = nwg % NXCD, xcd = wgid % NXCD, off = wgid / NXCD; wgid = (xcd < r ? xcd * (q + 1) : r * (q + 1) + (xcd - r) * q) + off; }
        const int nig = WGM * nN, gid = wgid / nig, fm = gid * WGM, gsz = (nM - fm) < WGM ? (nM - fm) : WGM;
        u.pm = fm + ((wgid % nig) % gsz); u.pn = (wgid % nig) / gsz; return true;
    }
    __device__ __forceinline__ void a_ready(const Unit&) const {}
    __device__ __forceinline__ void done(const Unit&) const {}
};

__device__ __forceinline__ unsigned cvt_pk_bf16(float lo, float hi) { unsigned r; asm volatile("v_cvt_pk_bf16_f32 %0, %1, %2" : "=v"(r) : "v"(lo), "v"(hi)); return r; }
typedef float f32x2 __attribute__((ext_vector_type(2)));
__device__ __forceinline__ float xadd16(float v) { auto r = __builtin_amdgcn_permlane16_swap(__float_as_uint(v), __float_as_uint(v), false, false); return __uint_as_float(r[0]) + __uint_as_float(r[1]); }
__device__ __forceinline__ float xadd32(float v) { auto r = __builtin_amdgcn_permlane32_swap(__float_as_uint(v), __float_as_uint(v), false, false); return __uint_as_float(r[0]) + __uint_as_float(r[1]); }
template <int CTRL> __device__ __forceinline__ float dpp_mov(float v) { return __builtin_bit_cast(float, __builtin_amdgcn_update_dpp(0, __builtin_bit_cast(int, v), CTRL, 0xf, 0xf, true)); }
__device__ __forceinline__ float row16_sum(float v) { v += dpp_mov<0xB1>(v); v += dpp_mov<0x4E>(v); v += dpp_mov<0x141>(v); v += dpp_mov<0x140>(v); return v; }
constexpr float QSCALE = 0.125f * 1.4426950408889634f;
constexpr size_t SS_LD = 73728;
__device__ __forceinline__ float row_rstd(const float* ss, int row, int fq) {
    const float* p = ss + (size_t)(4 * fq) * SS_LD + row;
    float s = (p[0] + p[SS_LD]) + (p[2 * SS_LD] + p[3 * SS_LD]);
    s += __shfl_xor(s, 16); s += __shfl_xor(s, 32);
    return __builtin_amdgcn_rsqf(s * (1.0f / 1024.0f) + 1e-6f);
}
struct EpiInProj {
    static constexpr bool PERM = true, AFTER_DRAIN = false;
    bf16_t* U; const PG8_LAS float* rope;
    const float* ss; const float* bias;
    __device__ __forceinline__ void operator()(const f32x4 (&acc)[2][2][4][2], const Unit& u, int wr, int wc, int fr, int fq) const {
        const bool latent = u.pm < 256;
        const int row0 = u.pm * BM + wr * 64 + fr;
        f32x4 bv[2][2];
        { const float* bp = bias + (size_t)(latent ? (u.pm >> 3) : 32) * 1536 + u.pn * BM + wc * 32 + 8 * fq;
#pragma unroll
          for (int bj = 0; bj < 2; ++bj)
#pragma unroll
              for (int n = 0; n < 2; ++n) bv[bj][n] = *(const f32x4*)(bp + bj * HALF + 4 * n); }
        if (u.pn == 3 || u.pn == 4) {
#pragma unroll
            for (int ai = 0; ai < 2; ++ai) { float r4[4];
#pragma unroll
                for (int m = 0; m < 4; ++m) r4[m] = row_rstd(ss, row0 + ai * HALF + m * 16, fq);
                asm volatile("" ::: "memory");
#pragma unroll
                for (int m = 0; m < 4; ++m) { const f32x2 rs2 = {r4[m], r4[m]}; const f32x2 one2 = {1.0f, 1.0f}; f32x2 hp[4];
#pragma unroll
                    for (int n = 0; n < 2; ++n)
#pragma unroll
                        for (int q = 0; q < 2; ++q) {
                            const f32x2 aa = {acc[ai][0][m][n][2 * q], acc[ai][0][m][n][2 * q + 1]}, ag = {acc[ai][1][m][n][2 * q], acc[ai][1][m][n][2 * q + 1]};
                            const f32x2 ba = {bv[0][n][2 * q], bv[0][n][2 * q + 1]}, bg = {bv[1][n][2 * q], bv[1][n][2 * q + 1]};
                            const f32x2 a = __builtin_elementwise_fma(aa, rs2, ba), g = __builtin_elementwise_fma(ag, rs2, bg);
                            f32x2 ex; ex.x = __builtin_amdgcn_exp2f(g.x); ex.y = __builtin_amdgcn_exp2f(g.y);
                            const f32x2 d = ex + one2; f32x2 r; r.x = __builtin_amdgcn_rcpf(d.x); r.y = __builtin_amdgcn_rcpf(d.y);
                            hp[2 * n + q] = a * r; }
                    u32x4 w; w.x = cvt_pk_bf16(hp[0].x, hp[0].y); w.y = cvt_pk_bf16(hp[1].x, hp[1].y); w.z = cvt_pk_bf16(hp[2].x, hp[2].y); w.w = cvt_pk_bf16(hp[3].x, hp[3].y);
                    *(u32x4*)(U + (size_t)(row0 + ai * HALF + m * 16) * 1536 + 768 + 128 * (u.pn - 3) + wc * 32 + 8 * fq) = w; }
                asm volatile("" ::: "memory"); }
            return;
        }
        const bool dorope = latent && (u.pn <= 2);
        const float sgn = (fq >> 1) ? 1.f : -1.f;
#pragma unroll
        for (int ai = 0; ai < 2; ++ai) {
            float r4[4];
#pragma unroll
            for (int m = 0; m < 4; ++m) r4[m] = row_rstd(ss, row0 + ai * HALF + m * 16, fq);
            asm volatile("" ::: "memory");
#pragma unroll
            for (int m = 0; m < 4; ++m) {
                const int row = row0 + ai * HALF + m * 16;
                const int pos = row & 2047; const int p = (wc & 1) ? (pos & 63) : (pos >> 6);
                const float rstd = r4[m];
                f32x4 c0 = {1.f, 1.f, 1.f, 1.f}, c1 = c0, s0 = {0.f, 0.f, 0.f, 0.f}, s1 = s0;
                if (dorope) { const PG8_LAS float* rp = rope + p * 16 + 8 * (fq & 1); c0 = *(const PG8_LAS f32x4*)rp; c1 = *(const PG8_LAS f32x4*)(rp + 4); s0 = *(const PG8_LAS f32x4*)(rp + 1024); s1 = *(const PG8_LAS f32x4*)(rp + 1028); }
#pragma unroll
                for (int bj = 0; bj < 2; ++bj) {
                    const int colw = u.pn * BM + bj * HALF + wc * 32;
                    const f32x2 rs2 = {rstd, rstd};
                    f32x2 v[4];
#pragma unroll
                    for (int n = 0; n < 2; ++n)
#pragma unroll
                        for (int q = 0; q < 2; ++q) v[2 * n + q] = __builtin_elementwise_fma((f32x2){acc[ai][bj][m][n][2 * q], acc[ai][bj][m][n][2 * q + 1]}, rs2, (f32x2){bv[bj][n][2 * q], bv[bj][n][2 * q + 1]});
                    if (dorope && colw < 640) {
                        const f32x2 sg2 = {sgn, sgn};
#pragma unroll
                        for (int k = 0; k < 4; ++k) { f32x2 p; p.x = __shfl_xor(v[k].x, 32); p.y = __shfl_xor(v[k].y, 32);
                            const f32x4 cc = (k < 2) ? c0 : c1, sn = (k < 2) ? s0 : s1;
                            const f32x2 c2 = {cc[2 * (k & 1)], cc[2 * (k & 1) + 1]}, s2 = {sn[2 * (k & 1)], sn[2 * (k & 1) + 1]};
                            v[k] = __builtin_elementwise_fma(v[k], c2, (p * s2) * sg2); }
                    }
                    u32x4 w; w.x = cvt_pk_bf16(v[0].x, v[0].y); w.y = cvt_pk_bf16(v[1].x, v[1].y); w.z = cvt_pk_bf16(v[2].x, v[2].y); w.w = cvt_pk_bf16(v[3].x, v[3].y);
                    *(u32x4*)(U + (size_t)row * 1536 + colw + 8 * fq) = w;
                }
            }
            asm volatile("" ::: "memory");
        }
    }
};
typedef unsigned u32x2 __attribute__((ext_vector_type(2)));
#ifndef EPI_DEPTH
#define EPI_DEPTH 1
#endif
struct EpiResid {
    static constexpr bool PERM = false, AFTER_DRAIN = false;
    const float* srcL; const float* srcC; float* dst; const float* gate;
    bf16_t* hb; float* ss; const float* ng; const float* nsc;
    PG8_LAS unsigned char* xp;
    __device__ __forceinline__ void operator()(const f32x4 (&acc)[2][2][4][2], const Unit& u, int wr, int wc, int fr, int fq) const {
        const bool latent = u.pm < 256;
        const int mrow = latent ? (u.pm >> 3) : 32;
        const int col0 = u.pn * BM + wc * 32 + 4 * fq;
        const float* gp = gate + (size_t)mrow * 12288 + col0;
        f32x4 gv[2][2];
#pragma unroll
        for (int bj = 0; bj < 2; ++bj)
#pragma unroll
            for (int n = 0; n < 2; ++n) gv[bj][n] = *(const f32x4*)(gp + bj * HALF + n * 16);
        f32x4 wn[2][2];
        if (hb) {
#pragma unroll
            for (int bj = 0; bj < 2; ++bj)
#pragma unroll
                for (int n = 0; n < 2; ++n) wn[bj][n] = *(const f32x4*)(ng + col0 + bj * HALF + n * 16) * (*(const f32x4*)(nsc + (size_t)mrow * 12288 + col0 + bj * HALF + n * 16) + 1.0f);
        }
        const int row0 = u.pm * BM + wr * 64 + fr;
        const float* src = latent ? srcL : (srcC - (size_t)65536 * 1024);
        const int l = fq * 16 + fr;
        PG8_LAS float* T = (PG8_LAS float*)(xp + (wr * 4 + wc) * 2304);
        PG8_LAS unsigned char* Tb = xp + (wr * 4 + wc) * 2304;
        constexpr int DEPTH = EPI_DEPTH;
        f32x4 rw[8][2][2];
#define EPI_LOAD(g_) do { const float* sp_ = src + (size_t)(u.pm * BM + ((g_) >> 2) * HALF + wr * 64 + ((g_) & 3) * 16 + (l >> 3)) * 1024 + u.pn * BM + wc * 32 + 4 * (l & 7); \
            _Pragma("unroll") for (int bj = 0; bj < 2; ++bj) { rw[g_][bj][0] = *(const f32x4*)(sp_ + bj * HALF); rw[g_][bj][1] = *(const f32x4*)(sp_ + bj * HALF + 8 * 1024); } } while (0)
#pragma unroll
        for (int g = 0; g < DEPTH; ++g) EPI_LOAD(g);
#pragma unroll
        for (int g = 0; g < 8; ++g) {
            const int ai = g >> 2, m = g & 3;
            f32x2 s2 = {0.f, 0.f};
            f32x4 o[2][2];
#pragma unroll
            for (int bj = 0; bj < 2; ++bj) {
                *(PG8_LAS f32x4*)(T + (l >> 3) * 36 + 4 * (l & 7)) = rw[g][bj][0]; *(PG8_LAS f32x4*)(T + (8 + (l >> 3)) * 36 + 4 * (l & 7)) = rw[g][bj][1];
                asm volatile("" ::: "memory");
                const f32x4 r0 = *(const PG8_LAS f32x4*)(T + fr * 36 + 4 * fq), r1 = *(const PG8_LAS f32x4*)(T + fr * 36 + 16 + 4 * fq);
                asm volatile("" ::: "memory");
#pragma unroll
                for (int n = 0; n < 2; ++n) { const f32x4 rr = n ? r1 : r0, gg = gv[bj][n], aa = acc[ai][bj][m][n];
                    const f32x2 ol = __builtin_elementwise_fma((f32x2){gg[0], gg[1]}, (f32x2){aa[0], aa[1]}, (f32x2){rr[0], rr[1]}), oh = __builtin_elementwise_fma((f32x2){gg[2], gg[3]}, (f32x2){aa[2], aa[3]}, (f32x2){rr[2], rr[3]});
                    o[bj][n] = (f32x4){ol.x, ol.y, oh.x, oh.y};
                    s2 = __builtin_elementwise_fma(ol, ol, s2); s2 = __builtin_elementwise_fma(oh, oh, s2); }
            }
            asm volatile("" ::: "memory");
            if (g + DEPTH < 8) EPI_LOAD(g + DEPTH);
            asm volatile("" ::: "memory");
            const size_t tbase = (size_t)(u.pm * BM + ai * HALF + wr * 64 + m * 16) * 1024 + u.pn * BM + wc * 32;
#pragma unroll
            for (int bj = 0; bj < 2; ++bj) {
                *(PG8_LAS f32x4*)(T + fr * 36 + 4 * fq) = o[bj][0]; *(PG8_LAS f32x4*)(T + fr * 36 + 16 + 4 * fq) = o[bj][1];
                asm volatile("" ::: "memory");
                const f32x4 a0 = *(const PG8_LAS f32x4*)(T + (l >> 3) * 36 + 4 * (l & 7)), a1 = *(const PG8_LAS f32x4*)(T + (8 + (l >> 3)) * 36 + 4 * (l & 7));
                asm volatile("" ::: "memory");
                float* dp = dst + tbase + bj * HALF + (size_t)(l >> 3) * 1024 + 4 * (l & 7);
                *(f32x4*)dp = a0; *(f32x4*)(dp + 8 * 1024) = a1;
                if (hb) { const f32x2 y0l = (f32x2){o[bj][0][0], o[bj][0][1]} * (f32x2){wn[bj][0][0], wn[bj][0][1]}, y0h = (f32x2){o[bj][0][2], o[bj][0][3]} * (f32x2){wn[bj][0][2], wn[bj][0][3]};
                    const f32x2 y1l = (f32x2){o[bj][1][0], o[bj][1][1]} * (f32x2){wn[bj][1][0], wn[bj][1][1]}, y1h = (f32x2){o[bj][1][2], o[bj][1][3]} * (f32x2){wn[bj][1][2], wn[bj][1][3]};
                    u32x2 w0, w1; w0.x = cvt_pk_bf16(y0l.x, y0l.y); w0.y = cvt_pk_bf16(y0h.x, y0h.y); w1.x = cvt_pk_bf16(y1l.x, y1l.y); w1.y = cvt_pk_bf16(y1h.x, y1h.y);
                    *(PG8_LAS u32x2*)(Tb + fr * 80 + 8 * fq) = w0; *(PG8_LAS u32x2*)(Tb + fr * 80 + 32 + 8 * fq) = w1;
                    asm volatile("" ::: "memory");
                    const u32x4 hv = *(const PG8_LAS u32x4*)(Tb + (l >> 2) * 80 + 16 * (l & 3));
                    asm volatile("" ::: "memory");
                    *(u32x4*)(hb + tbase + bj * HALF + (size_t)(l >> 2) * 1024 + 8 * (l & 3)) = hv; }
            }
            float s = s2.x + s2.y;
            s += __shfl_xor(s, 16); s += __shfl_xor(s, 32);
            if (fq == 0) ss[(size_t)(u.pn * 4 + wc) * SS_LD + row0 + ai * HALF + m * 16] = s;
        }
#undef EPI_LOAD
    }
};
struct EpiSwiGLU {
    static constexpr bool PERM = true, AFTER_DRAIN = false;
    bf16_t* O; const float* ss; const float* bias;
    __device__ __forceinline__ void operator()(const f32x4 (&acc)[2][2][4][2], const Unit& u, int wr, int wc, int fr, int fq) const {
        const int row0 = u.pm * BM + wr * 64 + fr; const int col0 = u.pn * HALF + wc * 32 + 8 * fq;
        f32x4 bv[2][2];
        { const float* bp = bias + (size_t)(u.pm < 256 ? (u.pm >> 3) : 32) * 5632 + u.pn * BM + wc * 32 + 8 * fq;
#pragma unroll
          for (int bj = 0; bj < 2; ++bj)
#pragma unroll
              for (int n = 0; n < 2; ++n) bv[bj][n] = *(const f32x4*)(bp + bj * HALF + 4 * n); }
        float rs[2][4];
#pragma unroll
        for (int ai = 0; ai < 2; ++ai)
#pragma unroll
            for (int m = 0; m < 4; ++m) rs[ai][m] = row_rstd(ss, row0 + ai * HALF + m * 16, fq);
        asm volatile("" ::: "memory");
#pragma unroll
        for (int ai = 0; ai < 2; ++ai)
#pragma unroll
            for (int m = 0; m < 4; ++m) {
                const f32x2 rs2 = {rs[ai][m], rs[ai][m]}; const f32x2 one2 = {1.0f, 1.0f};
                f32x2 hp[4];
#pragma unroll
                for (int n = 0; n < 2; ++n)
#pragma unroll
                    for (int q = 0; q < 2; ++q) {
                        const f32x2 ag = {acc[ai][0][m][n][2 * q], acc[ai][0][m][n][2 * q + 1]}, au = {acc[ai][1][m][n][2 * q], acc[ai][1][m][n][2 * q + 1]};
                        const f32x2 bg = {bv[0][n][2 * q], bv[0][n][2 * q + 1]}, bu = {bv[1][n][2 * q], bv[1][n][2 * q + 1]};
                        const f32x2 g = __builtin_elementwise_fma(ag, rs2, bg), uu = __builtin_elementwise_fma(au, rs2, bu);
                        f32x2 ex; ex.x = __builtin_amdgcn_exp2f(g.x); ex.y = __builtin_amdgcn_exp2f(g.y);
                        const f32x2 d = ex + one2; f32x2 r; r.x = __builtin_amdgcn_rcpf(d.x); r.y = __builtin_amdgcn_rcpf(d.y);
                        hp[2 * n + q] = (g * uu) * r; }
                u32x4 w; w.x = cvt_pk_bf16(hp[0].x, hp[0].y); w.y = cvt_pk_bf16(hp[1].x, hp[1].y); w.z = cvt_pk_bf16(hp[2].x, hp[2].y); w.w = cvt_pk_bf16(hp[3].x, hp[3].y);
                *(u32x4*)(O + (size_t)(row0 + ai * HALF + m * 16) * 2816 + col0) = w;
            }
    }
};
struct EpiMod {
    static constexpr bool PERM = false, AFTER_DRAIN = false;
    float* out; const float* bias; bf16_t* ash;
    __device__ __forceinline__ void operator()(const f32x4 (&acc)[2][2][4][2], const Unit& u, int wr, int wc, int fr, int fq) const {
        if (wr != 0) return;
        const int col0 = u.pn * BM + wc * 32 + 4 * fq;
#pragma unroll
        for (int m = 0; m < 3; ++m) { const int row = m * 16 + fr;
            if (row < 33) {
#pragma unroll
                for (int bj = 0; bj < 2; ++bj)
#pragma unroll
                    for (int n = 0; n < 2; ++n) { const int c = col0 + bj * HALF + n * 16; const f32x4 v = acc[0][bj][m][n] + *(const f32x4*)(bias + c); *(f32x4*)(out + (size_t)row * 12288 + c) = v;
                        const int l = c / 6144, q = (c % 6144) >> 10;
                        if (q == 0 || q == 3) { u32x2 w; w.x = cvt_pk_bf16(v[0], v[1]); w.y = cvt_pk_bf16(v[2], v[3]); *(u32x2*)(ash + (size_t)(l * 2 + (q == 3)) * 256 * 1024 + (size_t)row * 1024 + (c & 1023)) = w; } }
            } }
    }
};
struct EpiBias {
    static constexpr bool PERM = true, AFTER_DRAIN = false;
    float* out; int ldo;
    __device__ __forceinline__ void operator()(const f32x4 (&acc)[2][2][4][2], const Unit& u, int wr, int wc, int fr, int fq) const {
        if (wr != 0) return;
        const int col0 = u.pn * BM + wc * 32 + 8 * fq;
#pragma unroll
        for (int m = 0; m < 3; ++m) { const int row = m * 16 + fr;
            if (row < 33) {
#pragma unroll
                for (int bj = 0; bj < 2; ++bj)
#pragma unroll
                    for (int n = 0; n < 2; ++n) *(f32x4*)(out + (size_t)row * ldo + col0 + bj * HALF + n * 4) = acc[0][bj][m][n];
            } }
    }
};
struct SchedOne {
    int pn; bool on;
    __device__ bool next(int i, Unit& u) const { if (i != 0 || !on) return false; u.pm = 0; u.pn = pn; return true; }
    __device__ __forceinline__ void a_ready(const Unit&) const {}
    __device__ __forceinline__ void done(const Unit&) const {}
};
struct SchedMod {
    int c;
    __device__ bool next(int i, Unit& u) const { if (i != 0 || c >= 48) return false; u.pm = 0; u.pn = c; return true; }
    __device__ __forceinline__ void a_ready(const Unit&) const {}
    __device__ __forceinline__ void done(const Unit&) const {}
};
template <class Epi, class Sched, bool ALIGN_EPI = false, bool SP2 = false>
__device__ __forceinline__ void gemm_phase(PG8_LAS unsigned char* lds, const Gemm g, const Sched& S, const Epi& E) {
    int tid_ = threadIdx.x; asm volatile("" : "+v"(tid_));
    const int tid = tid_, wid = __builtin_amdgcn_readfirstlane(tid >> 6), lane = tid & 63, wr = wid >> 2, wc = wid & 3, fr = lane & 15, fq = lane >> 4;
    const int K = g.K, nt = K / BK;
    unsigned voffA[2], voffB[2];
#pragma unroll
    for (int i = 0; i < 2; ++i) { int R, C; stage_rc(tid * 16 + i * 8192, R, C); const int Rb = Epi::PERM ? ((R & ~31) + perm32(R & 31)) : R;
        voffA[i] = (unsigned)(R * K + C) * 2u; voffB[i] = (unsigned)(tid * 16 + i * 8192); (void)Rb; }
    const size_t kstep = (size_t)(BK * 2);
    const size_t hstep = (size_t)HALF * K * 2;
    const size_t tstep = 2 * hstep;
    const size_t kstepB = 32768, hstepB = 16384;
    const unsigned ldsw = (unsigned)wid * 1024u;
    const int aoff = lds_byte(wr * 64 + fr, fq * 8), boff = lds_byte(wc * 32 + fr, fq * 8);
#define PG8_SA(b, h) (((b) * 2 + (h)) * HTB)
#define PG8_SB(b, h) ((4 + (b) * 2 + (h)) * HTB)
#define PG8_STAGE(bufoff, gbase, voff) do { _Pragma("unroll") for (int _i = 0; _i < 2; ++_i) \
        __builtin_amdgcn_global_load_lds((const unsigned*)((const char*)(gbase) + (voff)[_i]), (PG8_LAS unsigned*)(lds + (bufoff) + ldsw + _i * 8192), 16, 0, 0); } while (0)
#define PG8_LDA(dst, b, h) do { _Pragma("unroll") for (int m = 0; m < 4; ++m) _Pragma("unroll") for (int k = 0; k < 2; ++k) dst[m][k] = *(const PG8_LAS bf16x8*)(lds + PG8_SA(b, h) + aoff + m * 2048 + k * 1024); } while (0)
#define PG8_LDB(dst, b, h) do { _Pragma("unroll") for (int n = 0; n < 2; ++n) _Pragma("unroll") for (int k = 0; k < 2; ++k) dst[n][k] = *(const PG8_LAS bf16x8*)(lds + PG8_SB(b, h) + boff + n * 2048 + k * 1024); } while (0)
#define PG8_MMA(ai, bj, At, Bt) do { __builtin_amdgcn_s_setprio(1); _Pragma("unroll") for (int m = 0; m < 4; ++m) _Pragma("unroll") for (int n = 0; n < 2; ++n) _Pragma("unroll") for (int k = 0; k < 2; ++k) \
        acc[ai][bj][m][n] = __builtin_amdgcn_mfma_f32_16x16x32_bf16(Bt[n][k], At[m][k], acc[ai][bj][m][n], 0, 0, 0); __builtin_amdgcn_s_setprio(0); } while (0)
#define PG8_WAIT_V(n) asm volatile("s_waitcnt vmcnt(" #n ")" ::: "memory")
#define PG8_WAIT_L(n) asm volatile("s_waitcnt lgkmcnt(" #n ")" ::: "memory")
#define PG8_BAR __builtin_amdgcn_s_barrier()
#define PG8_SCHED __builtin_amdgcn_sched_barrier(0)
    Unit cur, nxt; int ui = 0;
    if (!S.next(0, cur)) return;
    f32x4 acc[2][2][4][2];
#pragma unroll
    for (int a = 0; a < 2; ++a)
#pragma unroll
        for (int b = 0; b < 2; ++b)
#pragma unroll
            for (int m = 0; m < 4; ++m)
#pragma unroll
                for (int n = 0; n < 2; ++n) acc[a][b][m][n] = (f32x4){0.f, 0.f, 0.f, 0.f};
    bf16x8 At[4][2], B0[2][2], B1[2][2];
    const char* cA = (const char*)g.A + (size_t)cur.pm * tstep; const char* cB = (const char*)g.Bt + (size_t)cur.pn * tstep;
    S.a_ready(cur);
    if constexpr (SP2) {
        PG8_STAGE(PG8_SB(0, 0), cB, voffB); PG8_STAGE(PG8_SB(0, 1), cB + hstepB, voffB); PG8_STAGE(PG8_SA(0, 0), cA, voffA); PG8_STAGE(PG8_SA(0, 1), cA + hstep, voffA);
        if (wr == 1) PG8_BAR;
        PG8_WAIT_V(2); PG8_BAR;
        PG8_STAGE(PG8_SB(1, 0), cB + kstepB, voffB); PG8_STAGE(PG8_SA(1, 0), cA + kstep, voffA); PG8_STAGE(PG8_SB(1, 1), cB + hstepB + kstepB, voffB);
        PG8_WAIT_V(6); PG8_BAR;
    } else {
        PG8_STAGE(PG8_SB(0, 0), cB, voffB); PG8_STAGE(PG8_SA(0, 0), cA, voffA); PG8_STAGE(PG8_SB(0, 1), cB + hstepB, voffB); PG8_STAGE(PG8_SA(0, 1), cA + hstep, voffA);
        if (wr == 1) PG8_BAR;
        PG8_WAIT_V(4); PG8_BAR;
        PG8_STAGE(PG8_SB(1, 0), cB + kstepB, voffB); PG8_STAGE(PG8_SA(1, 0), cA + kstep, voffA); PG8_STAGE(PG8_SB(1, 1), cB + hstepB + kstepB, voffB);
        PG8_WAIT_V(6); PG8_BAR;
    }
    for (;;) {
        const bool has_next = S.next(ui + 1, nxt);
        const char* nA = has_next ? (const char*)g.A + (size_t)nxt.pm * tstep : cA; const char* nB = has_next ? (const char*)g.Bt + (size_t)nxt.pn * tstep : cB;
        for (int t = 0; t < nt; t += 2) {
            const bool last = (t == nt - 2);
            const char* a1 = cA + (size_t)(t + 1) * kstep;
            const char* a2 = last ? nA : cA + (size_t)(t + 2) * kstep; const char* b2 = last ? nB : cB + (size_t)(t + 2) * kstepB;
            const char* a3 = a2 + kstep; const char* b3 = b2 + kstepB;
            if (last && has_next) S.a_ready(nxt);
            if constexpr (SP2) {
            PG8_LDB(B0, 0, 0); PG8_LDB(B1, 0, 1); PG8_SCHED; PG8_LDA(At, 0, 0); PG8_STAGE(PG8_SA(1, 1), a1 + hstep, voffA);
            PG8_WAIT_V(8); PG8_WAIT_L(0); PG8_BAR; PG8_MMA(0, 0, At, B0); PG8_MMA(0, 1, At, B1); PG8_BAR; PG8_SCHED;
            PG8_LDA(At, 0, 1); PG8_STAGE(PG8_SB(0, 0), b2, voffB); PG8_STAGE(PG8_SB(0, 1), b2 + hstepB, voffB); PG8_STAGE(PG8_SA(0, 0), a2, voffA);
            PG8_WAIT_V(8); PG8_WAIT_L(0); PG8_BAR; PG8_MMA(1, 0, At, B0); PG8_MMA(1, 1, At, B1); PG8_BAR; PG8_SCHED;
            PG8_LDB(B0, 1, 0); PG8_LDB(B1, 1, 1); PG8_SCHED; PG8_LDA(At, 1, 0); PG8_STAGE(PG8_SA(0, 1), a2 + hstep, voffA);
            PG8_WAIT_V(8); PG8_WAIT_L(0); PG8_BAR; PG8_MMA(0, 0, At, B0); PG8_MMA(0, 1, At, B1); PG8_BAR; PG8_SCHED;
            PG8_LDA(At, 1, 1); PG8_STAGE(PG8_SB(1, 0), b3, voffB); PG8_STAGE(PG8_SB(1, 1), b3 + hstepB, voffB); PG8_STAGE(PG8_SA(1, 0), a3, voffA);
            PG8_WAIT_V(8); PG8_WAIT_L(0); PG8_BAR; PG8_MMA(1, 0, At, B0); PG8_MMA(1, 1, At, B1); PG8_BAR; PG8_SCHED;
            } else {
            PG8_LDB(B0, 0, 0); PG8_SCHED; PG8_LDA(At, 0, 0); PG8_STAGE(PG8_SA(1, 1), a1 + hstep, voffA);
            PG8_WAIT_L(8); PG8_BAR; PG8_WAIT_L(0); PG8_MMA(0, 0, At, B0); PG8_BAR; PG8_SCHED;
            PG8_LDB(B1, 0, 1); PG8_STAGE(PG8_SB(0, 0), b2, voffB);
            PG8_BAR; PG8_WAIT_L(0); PG8_MMA(0, 1, At, B1); PG8_BAR;
            PG8_LDA(At, 0, 1); PG8_STAGE(PG8_SA(0, 0), a2, voffA);
            PG8_BAR; PG8_WAIT_L(0); PG8_MMA(1, 0, At, B0); PG8_BAR; PG8_SCHED;
            PG8_STAGE(PG8_SB(0, 1), b2 + hstepB, voffB);
            PG8_WAIT_V(6); PG8_BAR; PG8_MMA(1, 1, At, B1); PG8_BAR;
            PG8_LDB(B0, 1, 0); PG8_SCHED; PG8_LDA(At, 1, 0); PG8_STAGE(PG8_SA(0, 1), a2 + hstep, voffA);
            PG8_WAIT_L(8); PG8_BAR; PG8_WAIT_L(0); PG8_MMA(0, 0, At, B0); PG8_BAR; PG8_SCHED;
            PG8_LDB(B1, 1, 1); PG8_STAGE(PG8_SB(1, 0), b3, voffB);
            PG8_BAR; PG8_WAIT_L(0); PG8_MMA(0, 1, At, B1); PG8_BAR;
            PG8_LDA(At, 1, 1); PG8_STAGE(PG8_SA(1, 0), a3, voffA);
            PG8_BAR; PG8_WAIT_L(0); PG8_MMA(1, 0, At, B0); PG8_BAR; PG8_SCHED;
            PG8_STAGE(PG8_SB(1, 1), b3 + hstepB, voffB);
            PG8_WAIT_V(6); PG8_BAR; PG8_MMA(1, 1, At, B1); PG8_BAR;
            }
        }
        if constexpr (ALIGN_EPI) { if (wr == 0) PG8_BAR; }
        if constexpr (!Epi::AFTER_DRAIN) { E(acc, cur, wr, wc, fr, fq); S.done(cur); }
        if (!has_next) break;
#pragma unroll
        for (int a = 0; a < 2; ++a)
#pragma unroll
            for (int b = 0; b < 2; ++b)
#pragma unroll
                for (int m = 0; m < 4; ++m)
#pragma unroll
                    for (int n = 0; n < 2; ++n) acc[a][b][m][n] = (f32x4){0.f, 0.f, 0.f, 0.f};
        cur = nxt; cA = nA; cB = nB; ++ui;
        if constexpr (ALIGN_EPI) { if (wr == 1) PG8_BAR; }
    }
    PG8_WAIT_V(0);
    if constexpr (!ALIGN_EPI) { if (wr == 0) PG8_BAR; }
    PG8_BAR;
    if constexpr (Epi::AFTER_DRAIN) { E.fused(acc, cur, wr, wc, fr, fq, lds, wid, lane); S.done(cur); }
#undef PG8_SA
#undef PG8_SB
#undef PG8_STAGE
#undef PG8_LDA
#undef PG8_LDB
#undef PG8_MMA
#undef PG8_WAIT_V
#undef PG8_WAIT_L
#undef PG8_BAR
#undef PG8_SCHED
}
}

constexpr int DM = 1024, NBATCH = 32, SEQ = 2048, NCTX = 256;
constexpr int ML = NBATCH * SEQ, MC = NBATCH * NCTX, MT = ML + MC;
constexpr int INW = 1536, DFF = 2816, NMOD = 6144;
constexpr float EPS = 1e-6f;
constexpr int NWAVES = 8;
#ifndef REP_P0
#define REP_P0 1
#endif
#ifndef REP_ATT
#define REP_ATT 1
#endif
#ifndef REP_G2
#define REP_G2 1
#endif
#ifndef REP_P0C
#define REP_P0C 1
#endif
#ifndef REP_MIX
#define REP_MIX 1
#endif
#ifndef REP_NORM
#define REP_NORM 1
#endif
#ifndef REP_G3
#define REP_G3 1
#endif
#ifndef REP_G1
#define REP_G1 1
#endif
#ifndef MK_SPLIT
#define MK_SPLIT 0
#endif

constexpr size_t MiB = 1u << 20;
constexpr size_t WS_CTL = 0;
constexpr size_t WS_ROPE = 1 * MiB, WS_MOD = 2 * MiB, WS_AMOD = 4 * MiB, WS_WMODT = 8 * MiB, WS_WINT = 32 * MiB, WS_WOUTT = 38 * MiB, WS_WF1T = 42 * MiB, WS_WF2T = 64 * MiB;
constexpr size_t WS_XS = 80 * MiB, WS_H = 368 * MiB, WS_U = 512 * MiB, WS_CAT = 728 * MiB, WS_ACT = 512 * MiB, WS_SS = 908 * MiB, WS_END = 916 * MiB;
constexpr size_t WS_ASH = 5 * MiB, WS_BIAS1 = 7 * MiB, WS_BIAS2 = 75 * MiB;
static_assert(WS_XS + (size_t)MT * DM * 4 <= WS_H && WS_H + (size_t)MT * DM * 2 <= WS_U && WS_U + (size_t)MT * INW * 2 <= WS_CAT && WS_CAT + (size_t)MT * DM * 2 <= WS_SS && WS_ACT + (size_t)MT * DFF * 2 <= WS_SS && WS_SS + (size_t)MT * 64 <= WS_END && WS_BIAS2 + (size_t)2 * 33 * 5632 * 4 <= WS_XS, "ws map");
static_assert(WS_WF2T + (size_t)2 * DM * DFF * 2 <= WS_XS && WS_WF1T + (size_t)2 * 2 * DFF * DM * 2 <= WS_WF2T && WS_WMODT + (size_t)2 * NMOD * DM * 2 <= WS_WINT, "ws map (weights)");

constexpr int RING_BYTES = 131072, LDS_BYTES = 163840, ROPE_LDS = RING_BYTES + 1024, XPOSE_LDS = ROPE_LDS + 8192;

static_assert(XPOSE_LDS + 8 * 2304 <= LDS_BYTES, "LDS map");
#define LAS __attribute__((address_space(3)))
typedef unsigned short bf16;
typedef unsigned v4u __attribute__((ext_vector_type(4)));
typedef unsigned v2u __attribute__((ext_vector_type(2)));
typedef float f32x4 __attribute__((ext_vector_type(4)));
typedef float f32x16 __attribute__((ext_vector_type(16)));
typedef short bf16x8 __attribute__((ext_vector_type(8)));
typedef float f32x2_t __attribute__((ext_vector_type(2)));
typedef __bf16 bf16x2_t __attribute__((ext_vector_type(2)));
__device__ __forceinline__ unsigned pk2(float lo, float hi) { f32x2_t v = {lo, hi}; bf16x2_t b = __builtin_convertvector(v, bf16x2_t); return __builtin_bit_cast(unsigned, b); }
__device__ __forceinline__ float bflo(unsigned w) { return __uint_as_float(w << 16); }
__device__ __forceinline__ float bfhi(unsigned w) { return __uint_as_float(w & 0xffff0000u); }
__device__ __forceinline__ float wave_sum(float v) { return pg8::xadd32(pg8::xadd16(pg8::row16_sum(v))); }
__device__ __forceinline__ float silu_f(float v) { return v * __builtin_amdgcn_rcpf(1.0f + __builtin_amdgcn_exp2f(v * -1.4426950408889634f)); }

struct Params {
    const float *x, *c, *ctx, *c_ctx, *w_mod, *b_mod, *n1g, *n2g, *w_in, *cdw, *cdwb, *clng, *clnb, *sink, *poolw, *pools, *w_out, *wf1, *wf2, *fing;
    float* out; unsigned char* ws;
    int ph_lo, ph_hi;
};

__device__ __forceinline__ size_t wimg_off(int row, int k, int K, bool perm) {
    const int r128 = row & 127; const int cc = r128 & 31;
    const int R = perm ? ((r128 & ~31) + 16 * ((cc >> 2) & 1) + 4 * (cc >> 3) + (cc & 3)) : r128;
    return ((size_t)((row >> 8) * (K >> 6) + (k >> 6)) * 32768 + (size_t)((row >> 7) & 1) * 16384 + (size_t)pg8::lds_byte(R, k & 63)) >> 1;
}
__device__ __forceinline__ void tr_item(const float* W, int ldw, bf16* WT, int ldt, int k0, int n0, int drow0, LAS float* scr, int lane, bool perm, float wscale = 1.0f) {
    { f32x4 wv[8];
#pragma unroll
      for (int i = 0; i < 8; ++i) wv[i] = *(const f32x4*)(W + (size_t)(k0 + 8 * i + (lane >> 3)) * ldw + n0 + 4 * (lane & 7));
#pragma unroll
      for (int i = 0; i < 8; ++i) { LAS float* d = scr + (8 * i + (lane >> 3)) * 33 + 4 * (lane & 7); d[0] = wv[i].x; d[1] = wv[i].y; d[2] = wv[i].z; d[3] = wv[i].w; } }
    asm volatile("s_waitcnt lgkmcnt(0)" ::: "memory");
    const int c = lane & 7;
#pragma unroll
    for (int j = 0; j < 4; ++j) { const int n = (lane >> 3) + 8 * j; const LAS float* s = scr + (8 * c) * 33 + n;
        v4u o; o.x = pk2(s[0 * 33] * wscale, s[1 * 33] * wscale); o.y = pk2(s[2 * 33] * wscale, s[3 * 33] * wscale); o.z = pk2(s[4 * 33] * wscale, s[5 * 33] * wscale); o.w = pk2(s[6 * 33] * wscale, s[7 * 33] * wscale);
        *(v4u*)(WT + wimg_off(drow0 + n, k0 + 8 * c, ldt, perm)) = o; }
    asm volatile("s_waitcnt lgkmcnt(0)" ::: "memory");
}
__device__ __forceinline__ void fold_item(const float* wout, const float* pw, const float* ps, bf16* WoutT, int g, int nc, int lane) {
    const int n = nc * 64 + lane;
    float w[64];
#pragma unroll
    for (int d = 0; d < 64; ++d) w[d] = wout[(size_t)(768 + 64 * g + d) * 1024 + n] * ps[64 * g + d];
    const float* pg = pw + (size_t)g * 4096;
    for (int c8 = 0; c8 < 8; ++c8) {
        float a[8];
#pragma unroll
        for (int cc = 0; cc < 8; ++cc) { const float* pr = pg + (c8 * 8 + cc) * 64; float s = 0.f;
#pragma unroll
            for (int d = 0; d < 64; ++d) s = fmaf(pr[d], w[d], s);
            a[cc] = s; }
        v4u o; o.x = pk2(a[0], a[1]); o.y = pk2(a[2], a[3]); o.z = pk2(a[4], a[5]); o.w = pk2(a[6], a[7]);
        *(v4u*)(WoutT + wimg_off(n, 768 + 64 * g + c8 * 8, 1024, false)) = o;
    }
}

__device__ __forceinline__ void phase_p0a(const Params& P, LAS unsigned char* lds, int G, int tid, int wave, int lane) {
    unsigned char* ws = P.ws;
    LAS float* scr = (LAS float*)(lds + wave * 16384);
    const int gw = blockIdx.x * NWAVES + wave, NGW = G * NWAVES;
    bf16* WmodT = (bf16*)(ws + WS_WMODT);
    for (int it = gw; it < 2 * 3072; it += NGW) { const int l = it / 3072, r = it % 3072, kb = r / 192, nb = r % 192;
        tr_item(P.w_mod + (size_t)l * 1024 * NMOD, NMOD, WmodT, 1024, 64 * kb, 32 * nb, l * NMOD + 32 * nb, scr, lane, false); }
    const int gt = blockIdx.x * 512 + tid, GT = G * 512;
    bf16* Amod = (bf16*)(ws + WS_AMOD);
    for (int i = gt; i < 256 * 128; i += GT) { const int row = i >> 7, c8 = (i & 127) * 8; v4u o = {0u, 0u, 0u, 0u};
        if (row < 33) { const float* s = (row < 32 ? P.c + (size_t)row * 1024 : P.c_ctx) + c8; const f32x4 a = *(const f32x4*)s, b = *(const f32x4*)(s + 4);
            o.x = pk2(silu_f(a[0]), silu_f(a[1])); o.y = pk2(silu_f(a[2]), silu_f(a[3])); o.z = pk2(silu_f(b[0]), silu_f(b[1])); o.w = pk2(silu_f(b[2]), silu_f(b[3])); }
        *(v4u*)(Amod + (size_t)row * 1024 + c8) = o; }
    float* rope = (float*)(ws + WS_ROPE);
    if (gt < 1024) { const int p = gt >> 4, i = gt & 15; const float inv = powf(10000.0f, -(float)(2 * i) / 32.0f); const float ang = (float)p * inv; float sn, cs; sincosf(ang, &sn, &cs); rope[gt] = cs; rope[1024 + gt] = sn; }
}
__device__ __forceinline__ void phase_p0b_convert(const Params& P, LAS unsigned char* lds, int G, int wave, int lane) {
    unsigned char* ws = P.ws;
    LAS float* scr = (LAS float*)(lds + wave * 16384);
    const int gw = ((int)blockIdx.x - 48) * NWAVES + wave, NGW = (G - 48) * NWAVES;
    constexpr int I_IN = 16 * 48, I_OUT = 12 * 32, I_F1 = 16 * 176, I_F2 = 44 * 32, I_FOLD = 64, I_L = I_IN + I_OUT + I_F1 + I_F2 + I_FOLD;
    for (int it = gw; it < 2 * I_L; it += NGW) {
        const int l = it / I_L; int r = it % I_L;
        if (r < I_FOLD) { fold_item(P.w_out + (size_t)l * 1024 * 1024, P.poolw + (size_t)l * 4 * 4096, P.pools + l * 256, (bf16*)(ws + WS_WOUTT) + (size_t)l * 1024 * 1024, r >> 4, r & 15, lane); continue; } r -= I_FOLD;
        if (r < I_IN) { const int kb = r / 48, nb = r % 48; const int n0 = 32 * nb; int drow = n0;
            if (n0 >= 768 && n0 < 1280) { const int isg = n0 >= 1024; const int ii = n0 - 768 - 256 * isg; drow = 768 + 256 * (ii >> 7) + 128 * isg + (ii & 127); }
            tr_item(P.w_in + (size_t)l * 1024 * INW, INW, (bf16*)(ws + WS_WINT) + (size_t)l * INW * 1024, 1024, 64 * kb, n0, drow, scr, lane, true, (n0 < 512) ? pg8::QSCALE : ((n0 >= 1024 && n0 < 1280) ? -1.4426950408889634f : 1.0f)); continue; } r -= I_IN;
        if (r < I_OUT) { const int kb = r / 32, nb = r % 32; tr_item(P.w_out + (size_t)l * 1024 * 1024, 1024, (bf16*)(ws + WS_WOUTT) + (size_t)l * 1024 * 1024, 1024, 64 * kb, 32 * nb, 32 * nb, scr, lane, false); continue; } r -= I_OUT;
        if (r < I_F1) { const int kb = r / 176, nb = r % 176; const int n0 = 32 * nb; const int isu = n0 >= DFF; const int nn = n0 - isu * DFF; const int drow = 256 * (nn / 128) + 128 * isu + (nn % 128);
            tr_item(P.wf1 + (size_t)l * 1024 * 2 * DFF, 2 * DFF, (bf16*)(ws + WS_WF1T) + (size_t)l * 2 * DFF * 1024, 1024, 64 * kb, n0, drow, scr, lane, true, isu ? -0.6931471805599453f : -1.4426950408889634f); continue; } r -= I_F1;
        { const int kb = r / 32, nb = r % 32; tr_item(P.wf2 + (size_t)l * DFF * 1024, 1024, (bf16*)(ws + WS_WF2T) + (size_t)l * 1024 * DFF, DFF, 64 * kb, 32 * nb, 32 * nb, scr, lane, false); }
    }
}

__device__ __forceinline__ void phase_norm0(const float* srcL, const float* srcC, bf16* HB, float* SS, const float* gvec, const float* mod_sc, int q0, int q1, int wave, int lane) {
    for (int q = q0 + wave; q < q1; q += NWAVES) {
        const int row = 4 * q; const bool latent = row < ML; const int mrow = latent ? (row >> 11) : 32;
        const f32x4* xr = (const f32x4*)(latent ? srcL + (size_t)row * DM : srcC + (size_t)(row - ML) * DM) + lane;
        f32x4 v[4][4];
#pragma unroll
        for (int i = 0; i < 4; ++i)
#pragma unroll
            for (int j = 0; j < 4; ++j) v[i][j] = xr[256 * i + 64 * j];
        float s[4];
#pragma unroll
        for (int i = 0; i < 4; ++i) { float a = 0.f;
#pragma unroll
            for (int j = 0; j < 4; ++j) a += (v[i][j].x * v[i][j].x + v[i][j].y * v[i][j].y) + (v[i][j].z * v[i][j].z + v[i][j].w * v[i][j].w);
            s[i] = wave_sum(a); }
        if (lane < 16) *(f32x4*)(SS + (size_t)lane * MT + row) = (lane == 0) ? (f32x4){s[0], s[1], s[2], s[3]} : (f32x4){0.f, 0.f, 0.f, 0.f};
        v2u* o8 = (v2u*)(HB + (size_t)row * DM) + lane;
#pragma unroll
        for (int j = 0; j < 4; ++j) { const int col = 4 * (lane + 64 * j);
            const f32x4 w = *(const f32x4*)(gvec + col) * (*(const f32x4*)(mod_sc + (size_t)mrow * 12288 + col) + 1.0f);
#pragma unroll
            for (int i = 0; i < 4; ++i) { const f32x4 y = v[i][j] * w; v2u o; o.x = pk2(y.x, y.y); o.y = pk2(y.z, y.w); o8[256 * i + 64 * j] = o; } }
    }
}
__device__ __forceinline__ void phase_final(const float* src, const float* SS, float* out, const float* gvec, int G, int wave, int lane) {
    const int gw = blockIdx.x * NWAVES + wave, NGW = G * NWAVES;
    f32x4 g[4];
#pragma unroll
    for (int j = 0; j < 4; ++j) g[j] = *(const f32x4*)(gvec + 4 * (lane + 64 * j));
    for (int row = 4 * gw; row < ML; row += 4 * NGW) {
        const f32x4* xr = (const f32x4*)(src + (size_t)row * DM) + lane;
        f32x4 v[4][4];
#pragma unroll
        for (int i = 0; i < 4; ++i)
#pragma unroll
            for (int j = 0; j < 4; ++j) v[i][j] = xr[256 * i + 64 * j];
        f32x4 t = *(const f32x4*)(SS + (size_t)(lane & 15) * MT + row);
        t.x = pg8::row16_sum(t.x); t.y = pg8::row16_sum(t.y); t.z = pg8::row16_sum(t.z); t.w = pg8::row16_sum(t.w);
        float rr[4];
        rr[0] = rsqrtf(t.x * (1.f / DM) + EPS); rr[1] = rsqrtf(t.y * (1.f / DM) + EPS); rr[2] = rsqrtf(t.z * (1.f / DM) + EPS); rr[3] = rsqrtf(t.w * (1.f / DM) + EPS);
        f32x4* o = (f32x4*)(out + (size_t)row * DM) + lane;
#pragma unroll
        for (int i = 0; i < 4; ++i)
#pragma unroll
            for (int j = 0; j < 4; ++j) o[256 * i + 64 * j] = (v[i][j] * rr[i]) * g[j];
    }
}

constexpr int KV_STRIDE = 144;
constexpr int KV_TILE = 64 * KV_STRIDE;
#define MFMA32(a, b, c) __builtin_amdgcn_mfma_f32_32x32x16_bf16((a), (b), (c), 0, 0, 0)
__device__ __forceinline__ int crow(int r, int h) { return (r & 3) + 8 * (r >> 2) + 4 * h; }
__device__ __forceinline__ void attn_unit(LAS unsigned char* lds, const bf16* U, bf16* CAT, const float* sinkp, int unit, int tid, int wave, int lane) {
    const int r32 = lane & 31, h = lane >> 5;
    int b, kvh, p0, qrow0; bool is_lat;
    if (unit < 1024) { b = unit >> 5; kvh = (unit >> 4) & 1; p0 = (unit & 15) * 128; qrow0 = b * SEQ + p0; is_lat = true; }
    else { const int cu = unit - 1024; b = cu >> 2; kvh = (cu >> 1) & 1; p0 = 0; qrow0 = ML + b * NCTX + (cu & 1) * 128; is_lat = false; }
    const int ctxrow0 = ML + b * NCTX;
    int lt_lo = 0, nt = 4;
    if (is_lat) { lt_lo = (p0 >= 128) ? 0 : 2; const int lt_hi = (p0 + 256 <= SEQ) ? 5 : 3; nt = 4 + lt_hi - lt_lo + 1; }
    const int head = kvh * 4 + (wave >> 1), qbase = 64 * (wave & 1);
    bf16x8 qf[2][4];
#pragma unroll
    for (int rt = 0; rt < 2; ++rt) { const bf16* qp = U + (size_t)(qrow0 + qbase + 32 * rt + r32) * INW + head * 64 + 8 * h;
#pragma unroll
      for (int d0 = 0; d0 < 4; ++d0) qf[rt][d0] = *(const bf16x8*)(qp + 16 * d0); }
    float m_run[2], l_run[2];
    f32x16 o[2][2];
#pragma unroll
    for (int rt = 0; rt < 2; ++rt) { m_run[rt] = sinkp[head] * 1.4426950408889634f; l_run[rt] = (h == 0) ? 1.f : 0.f;
#pragma unroll
      for (int r = 0; r < 16; ++r) { o[rt][0][r] = 0.f; o[rt][1][r] = 0.f; } }
    const int kkey = tid >> 3, kch = tid & 7;
    const int vkey = tid & 63, vch = tid >> 6;
    const int vslot = (vkey & ~15) + 8 * ((vkey >> 2) & 1) + 4 * ((vkey >> 3) & 1) + (vkey & 3);
    LAS unsigned char* Kb = lds; LAS unsigned char* Vb = lds + 2 * KV_TILE;
    const size_t kcol = 512 + kvh * 64 + kch * 8, vcol = 640 + kvh * 64 + vch * 8;
    v4u kreg, vreg;
#define TILE_ROW(t) ((t) < 4 ? ctxrow0 + 64 * (t) : b * SEQ + p0 - 128 + 64 * (lt_lo + (t) - 4))
#define LOAD_TILE(t) do { const int rb_ = TILE_ROW(t); kreg = *(const v4u*)(U + (size_t)(rb_ + kkey) * INW + kcol); vreg = *(const v4u*)(U + (size_t)(rb_ + vkey) * INW + vcol); } while (0)
#define STORE_TILE(buf) do { *(LAS v4u*)(Kb + (buf) * KV_TILE + kkey * KV_STRIDE + kch * 16) = kreg; \
        LAS unsigned short* vp_ = (LAS unsigned short*)(Vb + (buf) * KV_TILE + (vch * 8) * KV_STRIDE + vslot * 2); \
        vp_[0 * (KV_STRIDE / 2)] = (unsigned short)(vreg.x & 0xffffu); vp_[1 * (KV_STRIDE / 2)] = (unsigned short)(vreg.x >> 16); \
        vp_[2 * (KV_STRIDE / 2)] = (unsigned short)(vreg.y & 0xffffu); vp_[3 * (KV_STRIDE / 2)] = (unsigned short)(vreg.y >> 16); \
        vp_[4 * (KV_STRIDE / 2)] = (unsigned short)(vreg.z & 0xffffu); vp_[5 * (KV_STRIDE / 2)] = (unsigned short)(vreg.z >> 16); \
        vp_[6 * (KV_STRIDE / 2)] = (unsigned short)(vreg.w & 0xffffu); vp_[7 * (KV_STRIDE / 2)] = (unsigned short)(vreg.w >> 16); } while (0)
    __syncthreads();
    LOAD_TILE(0); STORE_TILE(0);
    __syncthreads();
    for (int t = 0; t < nt; ++t) {
        const int buf = t & 1;
        if (t + 1 < nt) LOAD_TILE(t + 1);
        const int lt = (t >= 4) ? lt_lo + t - 4 : 2;
        const int off = -128 + 64 * lt;
        const bool skip = (lt == 0 && qbase == 64) || (lt == 5 && qbase == 0);
        if (!skip) {
            const LAS unsigned char* kb = Kb + buf * KV_TILE + r32 * KV_STRIDE + 16 * h;
            const LAS unsigned char* vb = Vb + buf * KV_TILE + r32 * KV_STRIDE + 16 * h;
            f32x16 s[2][2];
#pragma unroll
            for (int rt = 0; rt < 2; ++rt)
#pragma unroll
                for (int r = 0; r < 16; ++r) { s[rt][0][r] = 0.f; s[rt][1][r] = 0.f; }
#pragma unroll
            for (int d0 = 0; d0 < 4; ++d0) {
                const bf16x8 k0 = *(const LAS bf16x8*)(kb + 32 * d0), k1 = *(const LAS bf16x8*)(kb + 32 * KV_STRIDE + 32 * d0);
                s[0][0] = MFMA32(k0, qf[0][d0], s[0][0]); s[0][1] = MFMA32(k1, qf[0][d0], s[0][1]);
                s[1][0] = MFMA32(k0, qf[1][d0], s[1][0]); s[1][1] = MFMA32(k1, qf[1][d0], s[1][1]);
            }
            const bool domask = (t >= 4) && (lt == 0 || lt == 1 || lt == 4 || lt == 5);
            v4u pf[2][4];
#pragma unroll
            for (int rt = 0; rt < 2; ++rt) {
                if (domask) { const int qi = qbase + 32 * rt + r32;
#pragma unroll
                    for (int r = 0; r < 16; ++r) { const int d0_ = crow(r, h) + off - qi, d1_ = d0_ + 32;
                        if (d0_ < -128 || d0_ > 128) s[rt][0][r] = -1e30f; if (d1_ < -128 || d1_ > 128) s[rt][1][r] = -1e30f; } }
                float mx = __builtin_fmaxf(__builtin_fmaxf(s[rt][0][0], s[rt][0][1]), s[rt][1][0]), mx2 = __builtin_fmaxf(__builtin_fmaxf(s[rt][0][2], s[rt][0][3]), s[rt][1][1]);
                mx = __builtin_fmaxf(__builtin_fmaxf(mx, s[rt][1][2]), s[rt][1][3]);
#pragma unroll
                for (int r = 4; r < 16; r += 4) { mx = __builtin_fmaxf(__builtin_fmaxf(mx, s[rt][0][r]), s[rt][0][r + 1]); mx2 = __builtin_fmaxf(__builtin_fmaxf(mx2, s[rt][0][r + 2]), s[rt][0][r + 3]);
                    mx = __builtin_fmaxf(__builtin_fmaxf(mx, s[rt][1][r]), s[rt][1][r + 1]); mx2 = __builtin_fmaxf(__builtin_fmaxf(mx2, s[rt][1][r + 2]), s[rt][1][r + 3]); }
                mx = __builtin_fmaxf(mx, mx2);
                { auto rr = __builtin_amdgcn_permlane32_swap(__float_as_uint(mx), __float_as_uint(mx), false, false); mx = __builtin_fmaxf(__uint_as_float(rr[0]), __uint_as_float(rr[1])); }
                if (__any(mx > m_run[rt] + 8.0f)) {
                    const float m_new = fmaxf(m_run[rt], mx), alpha = __builtin_amdgcn_exp2f(m_run[rt] - m_new);
                    m_run[rt] = m_new; l_run[rt] *= alpha;
#pragma unroll
                    for (int r = 0; r < 16; ++r) { o[rt][0][r] *= alpha; o[rt][1][r] *= alpha; }
                }
                const float m_ref = m_run[rt];
                float ps = 0.f, ps2 = 0.f;
#pragma unroll
                for (int r = 0; r < 16; ++r) { s[rt][0][r] = __builtin_amdgcn_exp2f(s[rt][0][r] - m_ref); s[rt][1][r] = __builtin_amdgcn_exp2f(s[rt][1][r] - m_ref); ps += s[rt][0][r]; ps2 += s[rt][1][r]; }
                l_run[rt] += ps + ps2;
                pf[rt][0] = (v4u){pk2(s[rt][0][0], s[rt][0][1]), pk2(s[rt][0][2], s[rt][0][3]), pk2(s[rt][0][4], s[rt][0][5]), pk2(s[rt][0][6], s[rt][0][7])};
                pf[rt][1] = (v4u){pk2(s[rt][0][8], s[rt][0][9]), pk2(s[rt][0][10], s[rt][0][11]), pk2(s[rt][0][12], s[rt][0][13]), pk2(s[rt][0][14], s[rt][0][15])};
                pf[rt][2] = (v4u){pk2(s[rt][1][0], s[rt][1][1]), pk2(s[rt][1][2], s[rt][1][3]), pk2(s[rt][1][4], s[rt][1][5]), pk2(s[rt][1][6], s[rt][1][7])};
                pf[rt][3] = (v4u){pk2(s[rt][1][8], s[rt][1][9]), pk2(s[rt][1][10], s[rt][1][11]), pk2(s[rt][1][12], s[rt][1][13]), pk2(s[rt][1][14], s[rt][1][15])};
            }
#pragma unroll
            for (int s4 = 0; s4 < 4; ++s4) {
                const bf16x8 v0 = *(const LAS bf16x8*)(vb + 32 * s4), v1 = *(const LAS bf16x8*)(vb + 32 * KV_STRIDE + 32 * s4);
                o[0][0] = MFMA32(v0, __builtin_bit_cast(bf16x8, pf[0][s4]), o[0][0]); o[0][1] = MFMA32(v1, __builtin_bit_cast(bf16x8, pf[0][s4]), o[0][1]);
                o[1][0] = MFMA32(v0, __builtin_bit_cast(bf16x8, pf[1][s4]), o[1][0]); o[1][1] = MFMA32(v1, __builtin_bit_cast(bf16x8, pf[1][s4]), o[1][1]);
            }
        }
        if (t + 1 < nt) STORE_TILE(buf ^ 1);
        __syncthreads();
    }
#undef TILE_ROW
#undef LOAD_TILE
#undef STORE_TILE
#pragma unroll
    for (int rt = 0; rt < 2; ++rt) {
        const float ltot = pg8::xadd32(l_run[rt]), inv = 1.0f / ltot;
        bf16* op = CAT + (size_t)(qrow0 + qbase + 32 * rt + r32) * DM + head * 64 + 4 * h;
#pragma unroll
        for (int g4 = 0; g4 < 4; ++g4) {
            v2u w0, w1;
            w0.x = pk2(o[rt][0][4 * g4] * inv, o[rt][0][4 * g4 + 1] * inv); w0.y = pk2(o[rt][0][4 * g4 + 2] * inv, o[rt][0][4 * g4 + 3] * inv);
            w1.x = pk2(o[rt][1][4 * g4] * inv, o[rt][1][4 * g4 + 1] * inv); w1.y = pk2(o[rt][1][4 * g4 + 2] * inv, o[rt][1][4 * g4 + 3] * inv);
            *(v2u*)(op + 8 * g4) = w0; *(v2u*)(op + 32 + 8 * g4) = w1;
        }
    }
}

__device__ __forceinline__ void convpool_phase(LAS unsigned char* lds, const bf16* U, bf16* CAT, const float* dw, const float* dwb, const float* lng, const float* lnb, int u0, int ustride, int nunits, int tid, int wave, int lane) {
    LAS float* hbuf = (LAS float*)lds;
    LAS float* cbuf = (LAS float*)(lds + 62 * 256 * 4);
    LAS unsigned char* pbuf = lds + 62 * 256 * 4 + 32 * 256 * 4;
    const int ch = tid & 31, rsub = tid >> 5, c = tid & 255, half = tid >> 8;
    float w[31];
#pragma unroll
    for (int j = 0; j < 31; ++j) w[j] = dw[j * 256 + c];
    const float bias = dwb[c];
    const f32x4 lg = *(const f32x4*)(lng + 4 * lane), lb = *(const f32x4*)(lnb + 4 * lane);
    const int gi = ch >> 3, win = 2 << gi;
    v4u pa[4], pp[3];
#define CP_PREFETCH(cv_) do { const int row0_ = (cv_) * 32; const bool lat_ = row0_ < ML; \
        const int seq0_ = lat_ ? (row0_ & ~(SEQ - 1)) : ML + ((row0_ - ML) & ~(NCTX - 1)); const int send_ = seq0_ + (lat_ ? SEQ : NCTX); \
        _Pragma("unroll") for (int q_ = 0; q_ < 4; ++q_) { const int rr_ = q_ * 16 + rsub; const int grow_ = row0_ - 15 + rr_; pa[q_] = (v4u){0u, 0u, 0u, 0u}; \
            if (rr_ < 62 && grow_ >= seq0_ && grow_ < send_) pa[q_] = *(const v4u*)(U + (size_t)grow_ * INW + 768 + 8 * ch); } \
        _Pragma("unroll") for (int q_ = 0; q_ < 3; ++q_) { const int grow_ = row0_ - 8 + q_ * 16 + rsub; pp[q_] = (v4u){0u, 0u, 0u, 0u}; \
            if (grow_ >= seq0_ && grow_ < send_) pp[q_] = *(const v4u*)(U + (size_t)grow_ * INW + 1280 + 8 * ch); } } while (0)
    if (u0 < nunits) CP_PREFETCH(u0);
    for (int cv = u0; cv < nunits; cv += ustride) {
        const int row0 = cv * 32; const bool latent = row0 < ML;
        const int seq0 = latent ? (row0 & ~(SEQ - 1)) : ML + ((row0 - ML) & ~(NCTX - 1)); const int slen = latent ? SEQ : NCTX;
        __syncthreads();
#pragma unroll
        for (int q = 0; q < 4; ++q) { const int rr = q * 16 + rsub; if (rr < 62) { const v4u a = pa[q];
            *(LAS f32x4*)(hbuf + rr * 256 + 8 * ch) = (f32x4){bflo(a.x), bfhi(a.x), bflo(a.y), bfhi(a.y)}; *(LAS f32x4*)(hbuf + rr * 256 + 8 * ch + 4) = (f32x4){bflo(a.z), bfhi(a.z), bflo(a.w), bfhi(a.w)}; } }
#pragma unroll
        for (int q = 0; q < 3; ++q) *(LAS v4u*)(pbuf + (q * 16 + rsub) * 512 + 16 * ch) = pp[q];
        __syncthreads();
        if (cv + ustride < nunits) CP_PREFETCH(cv + ustride);
        { float hv[46];
#pragma unroll
          for (int i = 0; i < 46; ++i) hv[i] = hbuf[(half * 16 + i) * 256 + c];
          float acc[16];
#pragma unroll
          for (int o = 0; o < 16; ++o) acc[o] = bias;
#pragma unroll
          for (int j = 0; j < 31; ++j) {
#pragma unroll
              for (int o = 0; o < 16; ++o) acc[o] = fmaf(w[j], hv[o + j], acc[o]); }
#pragma unroll
          for (int o = 0; o < 16; ++o) cbuf[(half * 16 + o) * 256 + c] = acc[o]; }
#pragma unroll
        for (int pss = 0; pss < 2; ++pss) { const int pos = pss * 16 + rsub; const int row = row0 + pos; const int t = row - seq0;
            int lo = t - (win >> 1); lo = lo < 0 ? 0 : lo; int hi = t + win - 1 - (win >> 1); hi = hi > slen - 1 ? slen - 1 : hi;
            float s[8];
#pragma unroll
            for (int e = 0; e < 8; ++e) s[e] = 0.f;
            const LAS unsigned char* pb = pbuf + (pos + 8 - (win >> 1)) * 512 + 16 * ch;
#pragma unroll
            for (int k = 0; k < 16; ++k) { if (k < win) { const v4u a = *(const LAS v4u*)(pb + k * 512);
                s[0] += bflo(a.x); s[1] += bfhi(a.x); s[2] += bflo(a.y); s[3] += bfhi(a.y); s[4] += bflo(a.z); s[5] += bfhi(a.z); s[6] += bflo(a.w); s[7] += bfhi(a.w); } }
            const float rc = 1.0f / (float)(hi - lo + 1);
            const v4u x = *(const LAS v4u*)(pbuf + (pos + 8) * 512 + 16 * ch);
            v4u o; o.x = pk2(s[0] * rc - bflo(x.x), s[1] * rc - bfhi(x.x)); o.y = pk2(s[2] * rc - bflo(x.y), s[3] * rc - bfhi(x.y));
            o.z = pk2(s[4] * rc - bflo(x.z), s[5] * rc - bfhi(x.z)); o.w = pk2(s[6] * rc - bflo(x.w), s[7] * rc - bfhi(x.w));
            *(v4u*)(CAT + (size_t)row * DM + 768 + 8 * ch) = o; }
        __syncthreads();
#pragma unroll
        for (int i = 0; i < 4; ++i) { const int r = wave * 4 + i; const f32x4 v = *(const LAS f32x4*)(cbuf + r * 256 + 4 * lane);
            const float mu = wave_sum((v.x + v.y) + (v.z + v.w)) * (1.f / 256.f); const f32x4 d = v - mu;
            const float var = wave_sum((d.x * d.x + d.y * d.y) + (d.z * d.z + d.w * d.w)) * (1.f / 256.f);
            const f32x4 hn = d * rsqrtf(var + EPS) * lg + lb;
            v2u o; o.x = pk2(silu_f(hn.x), silu_f(hn.y)); o.y = pk2(silu_f(hn.z), silu_f(hn.w));
            *(v2u*)(CAT + (size_t)(row0 + r) * DM + 512 + 4 * lane) = o; }
    }
#undef CP_PREFETCH
    __syncthreads();
}

#define RLX_AGENT __ATOMIC_RELAXED, __HIP_MEMORY_SCOPE_AGENT
#define XB_TMO      128
#define XB_XCNT(j)  (256  + 64 * (j))
#define XB_XSUB(j)  (1280 + 64 * (j))
#define XB_XGEN(j)  (2304 + 64 * (j))
#define XB_TOP      3328
#define XB_TOPGEN   3392
#define XCD_BAR_WORDS 3456
#define XB_SPIN_CAP (1u << 18)

__device__ __forceinline__ unsigned xb_ld(unsigned* p)              { return __hip_atomic_load(p, __ATOMIC_RELAXED, __HIP_MEMORY_SCOPE_AGENT); }
__device__ __forceinline__ unsigned xb_add(unsigned* p, unsigned v) { return __hip_atomic_fetch_add(p, v, __ATOMIC_RELAXED, __HIP_MEMORY_SCOPE_AGENT); }
__device__ __forceinline__ unsigned xb_xcc_id() { return (unsigned)__builtin_amdgcn_s_getreg((3 << 11) | 20) & 0xFu; }
#define XB_SPIN(cond, bar) do { unsigned _sp = 0; while (cond) { __builtin_amdgcn_s_sleep(1); \
    if ((++_sp & 255u) == 0u) { if (xb_ld(&(bar)[XB_TMO])) break; if (_sp > XB_SPIN_CAP) { atomicAdd(&(bar)[XB_TMO], 1u); break; } } } } while (0)

struct XcdBarrier {
    unsigned* bar; unsigned x;
    volatile LAS unsigned* st;
};

__device__ __forceinline__ XcdBarrier xcd_barrier_post(unsigned* bar, volatile LAS unsigned* st) {
    XcdBarrier b; b.bar = bar; b.x = xb_xcc_id(); b.st = st;
    if (threadIdx.x == 0) (void)xb_add(&bar[XB_XCNT(b.x)], 1u);
    return b;
}
__device__ __forceinline__ void xcd_barrier_complete(unsigned* bar, unsigned x, unsigned& nloc, unsigned& nx) {
    const unsigned G = gridDim.x * gridDim.y * gridDim.z;
    unsigned sum, cnt, mine, sp = 0u;
    for (;;) {
        sum = 0u; cnt = 0u; mine = 0u;
#pragma unroll
        for (unsigned j = 0; j < 16; ++j) { const unsigned c = xb_ld(&bar[XB_XCNT(j)]); sum += c; cnt += (c > 0u) ? 1u : 0u; mine = (j == x) ? c : mine; }
        if (sum == G) break;
        __builtin_amdgcn_s_sleep(1);
        if ((++sp & 255u) == 0u) { if (xb_ld(&bar[XB_TMO])) break; if (sp > XB_SPIN_CAP) { atomicAdd(&bar[XB_TMO], 1u); break; } }
    }
    nloc = mine > 0u ? mine : 1u; nx = cnt > 0u ? cnt : 1u;
}

__device__ __forceinline__ void xcd_barrier(const XcdBarrier& b) {
    asm volatile("s_waitcnt vmcnt(0)" ::: "memory");
    __syncthreads();
    if (threadIdx.x == 0) {
        unsigned* bar = b.bar;
        __builtin_amdgcn_s_waitcnt(0);
        unsigned nloc = b.st[0], nx = b.st[1];
        if (nloc == 0u) { xcd_barrier_complete(bar, b.x, nloc, nx); b.st[0] = nloc; b.st[1] = nx; }
        const unsigned old = xb_add(&bar[XB_XSUB(b.x)], 1u);
        const unsigned gen = old / nloc;
        if (old + 1u == (gen + 1u) * nloc) {
            __builtin_amdgcn_fence(__ATOMIC_RELEASE, "agent");
            asm volatile("s_waitcnt vmcnt(0)" ::: "memory");
            const unsigned og = xb_add(&bar[XB_TOP], 1u);
            const unsigned tg = og / nx;
            if (og + 1u == (tg + 1u) * nx) xb_add(&bar[XB_TOPGEN], 1u);
            else XB_SPIN(xb_ld(&bar[XB_TOPGEN]) == tg, bar);
            __builtin_amdgcn_fence(__ATOMIC_ACQUIRE, "agent");
            xb_add(&bar[XB_XGEN(b.x)], 1u);
            asm volatile("s_waitcnt vmcnt(0)" ::: "memory");
        } else {
            XB_SPIN(xb_ld(&bar[XB_XGEN(b.x)]) == gen, bar);
            __builtin_amdgcn_fence(__ATOMIC_ACQUIRE, "agent");
            asm volatile("s_waitcnt vmcnt(0)" ::: "memory");
        }
    }
    __syncthreads();
}

__global__ void __launch_bounds__(NWAVES * 64, 2) fwd_megakernel(Params P) {
    extern __shared__ __attribute__((aligned(16))) unsigned char lds_raw[];
    LAS unsigned char* lds = (LAS unsigned char*)lds_raw;
    cg::grid_group grid = cg::this_grid();
    volatile LAS unsigned* MISC = (volatile LAS unsigned*)(lds + RING_BYTES);
    if (threadIdx.x < 64) MISC[threadIdx.x] = 0u;
    __syncthreads();
    if (!MK_SPLIT && blockIdx.x == 0) { unsigned* bw = (unsigned*)(P.ws + WS_CTL); for (int i = threadIdx.x; i < XCD_BAR_WORDS; i += NWAVES * 64) bw[i] = 0u; __threadfence(); }
    XcdBarrier bar; bar.bar = (unsigned*)(P.ws + WS_CTL); bar.x = 0; bar.st = MISC + 8;
    const int G = gridDim.x;
#define FRESH_TID() int tid = threadIdx.x; asm volatile("" : "+v"(tid)); const int lane = tid & 63, wave = __builtin_amdgcn_readfirstlane(tid >> 6); (void)lane; (void)wave
    unsigned char* ws = P.ws;
    float* rope = (float*)(ws + WS_ROPE); float* modb = (float*)(ws + WS_MOD);
    bf16* Amod = (bf16*)(ws + WS_AMOD); bf16* WmodT = (bf16*)(ws + WS_WMODT); bf16* Ash = (bf16*)(ws + WS_ASH); float* bias1 = (float*)(ws + WS_BIAS1); float* bias2 = (float*)(ws + WS_BIAS2); float* SS = (float*)(ws + WS_SS);
    float* XS = (float*)(ws + WS_XS); bf16* H = (bf16*)(ws + WS_H); bf16* U = (bf16*)(ws + WS_U); bf16* CAT = (bf16*)(ws + WS_CAT); bf16* ACT = (bf16*)(ws + WS_ACT);
    const int lo = P.ph_lo, hi = P.ph_hi;
    int ph = 0;
#define IN_PH() (lo <= ph && ph < hi)
#ifndef STG_G2
#define STG_G2 0
#endif
#ifndef STG_G4
#define STG_G4 0
#endif
#define STAGGER(ticks) do { const unsigned grp_ = (blockIdx.x >> 3) & 1u; if ((ticks) > 0 && grp_ && threadIdx.x == 0) { const unsigned long long t0_ = __builtin_amdgcn_s_memrealtime(); \
        while (__builtin_amdgcn_s_memrealtime() - t0_ < (unsigned long long)(ticks) * grp_) __builtin_amdgcn_s_sleep(8); } __syncthreads(); } while (0)
#define SEAM() do { if (!MK_SPLIT) { if (ph == 0) { grid.sync(); bar = xcd_barrier_post((unsigned*)(P.ws + WS_CTL), MISC + 8); } else xcd_barrier(bar); } ++ph; } while (0)

    if (IN_PH()) { FRESH_TID(); phase_p0a(P, lds, G, tid, wave, lane); }
    SEAM();
    if (IN_PH()) {
        if (blockIdx.x < 48) { pg8::Gemm g{Amod, WmodT, 256, 2 * NMOD, DM}; pg8::SchedMod S{(int)blockIdx.x}; pg8::EpiMod E{modb, P.b_mod, Ash};
            pg8::gemm_phase<pg8::EpiMod, pg8::SchedMod, false, true>(lds, g, S, E); }
        else { FRESH_TID(); phase_p0b_convert(P, lds, G, wave, lane); }
    }
    SEAM();
    if (IN_PH()) for (int rep = 0; rep < REP_P0C; ++rep) {
        const int bx = blockIdx.x;
        if (bx < 56) {
            const int l = bx / 28, r = bx % 28, which = r >= 6, pn = which ? r - 6 : r;
            const bf16* Bt = which ? (const bf16*)(ws + WS_WF1T) + (size_t)l * 2 * DFF * DM : (const bf16*)(ws + WS_WINT) + (size_t)l * INW * DM;
            float* outp = which ? bias2 + (size_t)l * 33 * 2 * DFF : bias1 + (size_t)l * 33 * INW;
            pg8::Gemm g{Ash + (size_t)(l * 2 + which) * 256 * 1024, Bt, 256, which ? 2 * DFF : INW, DM}; pg8::SchedOne S{pn, true}; pg8::EpiBias E{outp, which ? 2 * DFF : INW};
            pg8::gemm_phase<pg8::EpiBias, pg8::SchedOne, false, true>(lds, g, S, E);
        }
        { FRESH_TID(); (void)tid;
          constexpr int NQ = MT / 4, QG = 56, WGQ = 56;
          const int nn = G - QG; const int per = (NQ - QG * WGQ + nn - 1) / nn;
          int q0, q1; if (bx < QG) { q0 = bx * WGQ; q1 = q0 + WGQ; } else { q0 = QG * WGQ + (bx - QG) * per; q1 = q0 + per; if (q1 > NQ) q1 = NQ; }
          phase_norm0(P.x, P.ctx, H, SS, P.n1g, modb + 1 * 1024, q0, q1, wave, lane); }
    }
    SEAM();
#pragma unroll 1
    for (int l = 0; l < 2; ++l) {
        const bool last = (l == 1);
        const float* mod_l = modb + l * NMOD;
        const float* srcL = (l == 0) ? P.x : XS; const float* srcC = (l == 0) ? P.ctx : XS + (size_t)ML * DM;
        const int Mff = last ? ML : MT;
        if (IN_PH()) for (int rep = 0; rep < REP_G1; ++rep) { { LAS float* rl = (LAS float*)(lds + ROPE_LDS); for (int i = threadIdx.x; i < 2048; i += 512) rl[i] = rope[i]; __syncthreads(); }
            pg8::Gemm g{H, (const bf16*)(ws + WS_WINT) + (size_t)l * INW * DM, MT, INW, DM}; pg8::StaticOrder S; S.init(MT, INW, G, (int)blockIdx.x); pg8::EpiInProj E{U, (const LAS float*)(lds + ROPE_LDS), SS, bias1 + (size_t)l * 33 * INW};
            pg8::gemm_phase<pg8::EpiInProj, pg8::StaticOrder, true, true>(lds, g, S, E); }
        SEAM();
        if (IN_PH()) for (int rep = 0; rep < REP_MIX; ++rep) {
            FRESH_TID(); const int NA = last ? 1024 : 1152, NCV = last ? (ML / 32) : (MT / 32);
            for (int ra = 0; ra < REP_ATT; ++ra) for (int u = blockIdx.x; u < NA; u += G) attn_unit(lds, U, CAT, P.sink + l * 8, u, tid, wave, lane);
            convpool_phase(lds, U, CAT, P.cdw + l * 31 * 256, P.cdwb + l * 256, P.clng + l * 256, P.clnb + l * 256, (int)blockIdx.x, G, NCV, tid, wave, lane);
        }
        SEAM();
        if (IN_PH()) for (int rep = 0; rep < ((l == 0) ? REP_G2 : 1); ++rep) { STAGGER(STG_G2); pg8::Gemm g{CAT, (const bf16*)(ws + WS_WOUTT) + (size_t)l * DM * DM, Mff, DM, DM}; pg8::StaticOrder S; S.init(Mff, DM, G, (int)blockIdx.x);
            pg8::EpiResid E{srcL, srcC, XS, mod_l + 2 * 1024, H, SS, P.n2g + l * DM, mod_l + 4 * 1024, lds + XPOSE_LDS};
            pg8::gemm_phase<pg8::EpiResid, pg8::StaticOrder, true, true>(lds, g, S, E); }
        SEAM();
        if (IN_PH()) for (int rep = 0; rep < REP_G3; ++rep) { pg8::Gemm g{H, (const bf16*)(ws + WS_WF1T) + (size_t)l * 2 * DFF * DM, Mff, 2 * DFF, DM}; pg8::StaticOrder S; S.init(Mff, 2 * DFF, G, (int)blockIdx.x); pg8::EpiSwiGLU E{ACT, SS, bias2 + (size_t)l * 33 * 2 * DFF};
            pg8::gemm_phase<pg8::EpiSwiGLU, pg8::StaticOrder, true, true>(lds, g, S, E); }
        SEAM();
        if (IN_PH()) { pg8::Gemm g{ACT, (const bf16*)(ws + WS_WF2T) + (size_t)l * DM * DFF, Mff, DM, DFF}; pg8::StaticOrder S; S.init(Mff, DM, G, (int)blockIdx.x);
            pg8::EpiResid E{XS, XS + (size_t)ML * DM, XS, mod_l + 5 * 1024, last ? (bf16*)nullptr : H, SS, P.n1g + DM, modb + NMOD + 1 * 1024, lds + XPOSE_LDS};
            pg8::gemm_phase<pg8::EpiResid, pg8::StaticOrder, true, true>(lds, g, S, E); }
        SEAM();
    }
    if (IN_PH()) { FRESH_TID(); (void)tid; phase_final(XS, SS, P.out, P.fing, G, wave, lane); }
#undef IN_PH
#undef SEAM
}
constexpr int N_PHASES = 3 + 2 * 5 + 1;

extern "C" void kernel_launch(void* const* d_in, const int* in_sizes, int n_in, void* d_out, int out_size, void* d_ws, size_t ws_size, hipStream_t stream) {
    static int grid = 0;
    if (grid == 0) {
        if (n_in != 20 || ws_size < WS_END) { fprintf(stderr, "kernel_launch: unexpected n_in %d or ws_size %zu (need %zu)\n", n_in, ws_size, (size_t)WS_END); grid = -1; return; }
        int dev = 0, cus = 0, per_cu = 0;
        hipGetDevice(&dev); hipDeviceGetAttribute(&cus, hipDeviceAttributeMultiprocessorCount, dev);
        if (hipFuncSetAttribute((const void*)fwd_megakernel, hipFuncAttributeMaxDynamicSharedMemorySize, LDS_BYTES) != hipSuccess) { fprintf(stderr, "kernel_launch: hipFuncSetAttribute failed\n"); grid = -1; return; }
        if (hipOccupancyMaxActiveBlocksPerMultiprocessor(&per_cu, (const void*)fwd_megakernel, NWAVES * 64, LDS_BYTES) != hipSuccess || per_cu < 1) { fprintf(stderr, "kernel_launch: occupancy query says %d\n", per_cu); per_cu = 1; }
        (void)hipGetLastError();
        grid = cus * per_cu;
        if (grid > 256) grid = 256;
        fprintf(stderr, "kernel_launch: grid %d (cus %d, per_cu %d)\n", grid, cus, per_cu);
    }
    if (grid < 0) return;
    Params p{};
    const float** pp = (const float**)&p;
    for (int i = 0; i < 20; ++i) pp[i] = (const float*)d_in[i];
    p.out = (float*)d_out; p.ws = (unsigned char*)d_ws;
#if MK_SPLIT
    for (int k = 0; k < N_PHASES; ++k) { p.ph_lo = k; p.ph_hi = k + 1; hipLaunchKernelGGL(fwd_megakernel, dim3(grid), dim3(NWAVES * 64), LDS_BYTES, stream, p); }
#else
    p.ph_lo = 0; p.ph_hi = N_PHASES;
    void* args[] = {&p};
    hipError_t e = hipLaunchCooperativeKernel((const void*)fwd_megakernel, dim3(grid), dim3(NWAVES * 64), args, LDS_BYTES, stream);
    if (e != hipSuccess) fprintf(stderr, "kernel_launch: cooperative launch failed: %s (grid %d)\n", hipGetErrorString(e), grid);
#endif
}
```

```cpp
#include <hip/hip_runtime.h>
#include <hip/hip_cooperative_groups.h>
#include <cstdio>
#include <cstdint>
namespace cg = cooperative_groups;
namespace pg8 {
#define PG8_LAS __attribute__((address_space(3)))
typedef unsigned short bf16_t;
typedef short bf16x8 __attribute__((ext_vector_type(8)));
typedef float f32x4 __attribute__((ext_vector_type(4)));
typedef unsigned u32x4 __attribute__((ext_vector_type(4)));
constexpr int BM = 256, BK = 64, HALF = 128, HTB = HALF * BK * 2  , STAGE_BYTES = 8 * HTB, NXCD = 8, WGM = 4;

__host__ __device__ __forceinline__ int lds_byte(int r, int c) { const int st = (r >> 4) * 2 + (c >> 5), rr = r & 15, cc = c & 31, ob = rr * 64 + cc * 2; return st * 1024 + (ob ^ (((ob >> 9) & 1) << 5)); }
__host__ __device__ __forceinline__ void stage_rc(int b, int& R, int& C) { const int st = b / 1024, sb = b % 1024, swz = sb ^ (((sb >> 9) & 1) << 5); R = (st >> 1) * 16 + swz / 64; C = (st & 1) * 32 + (swz % 64) / 2; }
__host__ __device__ __forceinline__ int perm32(int rho) { const int n = rho >> 4, i = rho & 15; return 8 * (i >> 2) + 4 * n + (i & 3); }

struct Unit { int pm, pn; };
struct Gemm { const bf16_t* A; const bf16_t* Bt; int M, N, K; };

struct StaticOrder {
    int nM, nN, nwg, G, c;
    __host__ __device__ void init(int M, int N, int G_, int c_) { nM = M / BM; nN = N / BM; nwg = nM * nN; G = G_; c = c_; }
    __host__ __device__ bool next(int i, Unit& u) const {
        const long L = (long)i * G + c; if (L >= nwg) return false;
        int wgid = (int)L; { const int q = nwg / NXCD, r = nwg % NXCD, xcd = wgid % NXCD, off = wgid / NXCD; wgid = (xcd < r ? xcd * (q + 1) : r * (q + 1) + (xcd - r) * q) + off; }
        const int nig = WGM * nN, gid = wgid / nig, fm = gid * WGM, gsz = (nM - fm) < WGM ? (nM - fm) : WGM;
        u.pm = fm + ((wgid % nig) % gsz); u.pn = (wgid % nig) / gsz; return true;
    }
    __device__ __forceinline__ void a_ready(const Unit&) const {}
    __device__ __forceinline__ void done(const Unit&) const {}
};

__device__ __forceinline__ unsigned cvt_pk_bf16(float lo, float hi) { unsigned r; asm volatile("v_cvt_pk_bf16_f32 %0, %1, %2" : "=v"(r) : "v"(lo), "v"(hi)); return r; }
typedef float f32x2 __attribute__((ext_vector_type(2)));
__device__ __forceinline__ float xadd16(float v) { auto r = __builtin_amdgcn_permlane16_swap(__float_as_uint(v), __float_as_uint(v), false, false); return __uint_as_float(r[0]) + __uint_as_float(r[1]); }
__device__ __forceinline__ float xadd32(float v) { auto r = __builtin_amdgcn_permlane32_swap(__float_as_uint(v), __float_as_uint(v), false, false); return __uint_as_float(r[0]) + __uint_as_float(r[1]); }
template <int CTRL> __device__ __forceinline__ float dpp_mov(float v) { return __builtin_bit_cast(float, __builtin_amdgcn_update_dpp(0, __builtin_bit_cast(int, v), CTRL, 0xf, 0xf, true)); }
__device__ __forceinline__ float row16_sum(float v) { v += dpp_mov<0xB1>(v); v += dpp_mov<0x4E>(v); v += dpp_mov<0x141>(v); v += dpp_mov<0x140>(v); return v; }
constexpr float QSCALE = 0.125f * 1.4426950408889634f;
constexpr size_t SS_LD = 73728;
__device__ __forceinline__ float row_rstd(const float* ss, int row, int fq) {
    const float* p = ss + (size_t)(4 * fq) * SS_LD + row;
    float s = (p[0] + p[SS_LD]) + (p[2 * SS_LD] + p[3 * SS_LD]);
    s += __shfl_xor(s, 16); s += __shfl_xor(s, 32);
    return __builtin_amdgcn_rsqf(s * (1.0f / 1024.0f) + 1e-6f);
}
struct EpiInProj {
    static constexpr bool PERM = true, AFTER_DRAIN = false;
    bf16_t* U; const PG8_LAS float* rope;
    const float* ss; const float* bias;
    __device__ __forceinline__ void operator()(const f32x4 (&acc)[2][2][4][2], const Unit& u, int wr, int wc, int fr, int fq) const {
        const bool latent = u.pm < 256;
        const int row0 = u.pm * BM + wr * 64 + fr;
        f32x4 bv[2][2];
        { const float* bp = bias + (size_t)(latent ? (u.pm >> 3) : 32) * 1536 + u.pn * BM + wc * 32 + 8 * fq;
#pragma unroll
          for (int bj = 0; bj < 2; ++bj)
#pragma unroll
              for (int n = 0; n < 2; ++n) bv[bj][n] = *(const f32x4*)(bp + bj * HALF + 4 * n); }
        if (u.pn == 3 || u.pn == 4) {
#pragma unroll
            for (int ai = 0; ai < 2; ++ai) { float r4[4];
#pragma unroll
                for (int m = 0; m < 4; ++m) r4[m] = row_rstd(ss, row0 + ai * HALF + m * 16, fq);
                asm volatile("" ::: "memory");
#pragma unroll
                for (int m = 0; m < 4; ++m) { const f32x2 rs2 = {r4[m], r4[m]}; const f32x2 nl2 = {-1.4426950408889634f, -1.4426950408889634f}, one2 = {1.0f, 1.0f}; f32x2 hp[4];
#pragma unroll
                    for (int n = 0; n < 2; ++n)
#pragma unroll
                        for (int q = 0; q < 2; ++q) {
                            const f32x2 aa = {acc[ai][0][m][n][2 * q], acc[ai][0][m][n][2 * q + 1]}, ag = {acc[ai][1][m][n][2 * q], acc[ai][1][m][n][2 * q + 1]};
                            const f32x2 ba = {bv[0][n][2 * q], bv[0][n][2 * q + 1]}, bg = {bv[1][n][2 * q], bv[1][n][2 * q + 1]};
                            const f32x2 a = __builtin_elementwise_fma(aa, rs2, ba), g = __builtin_elementwise_fma(ag, rs2, bg);
                            const f32x2 t = g * nl2; f32x2 ex; ex.x = __builtin_amdgcn_exp2f(t.x); ex.y = __builtin_amdgcn_exp2f(t.y);
                            const f32x2 d = ex + one2; f32x2 r; r.x = __builtin_amdgcn_rcpf(d.x); r.y = __builtin_amdgcn_rcpf(d.y);
                            hp[2 * n + q] = a * r; }
                    u32x4 w; w.x = cvt_pk_bf16(hp[0].x, hp[0].y); w.y = cvt_pk_bf16(hp[1].x, hp[1].y); w.z = cvt_pk_bf16(hp[2].x, hp[2].y); w.w = cvt_pk_bf16(hp[3].x, hp[3].y);
                    *(u32x4*)(U + (size_t)(row0 + ai * HALF + m * 16) * 1536 + 768 + 128 * (u.pn - 3) + wc * 32 + 8 * fq) = w; }
                asm volatile("" ::: "memory"); }
            return;
        }
        const bool dorope = latent && (u.pn <= 2);
        const float sgn = (fq >> 1) ? 1.f : -1.f;
#pragma unroll
        for (int ai = 0; ai < 2; ++ai) {
            float r4[4];
#pragma unroll
            for (int m = 0; m < 4; ++m) r4[m] = row_rstd(ss, row0 + ai * HALF + m * 16, fq);
            asm volatile("" ::: "memory");
#pragma unroll
            for (int m = 0; m < 4; ++m) {
                const int row = row0 + ai * HALF + m * 16;
                const int pos = row & 2047; const int p = (wc & 1) ? (pos & 63) : (pos >> 6);
                const float rstd = r4[m];
                f32x4 c0 = {1.f, 1.f, 1.f, 1.f}, c1 = c0, s0 = {0.f, 0.f, 0.f, 0.f}, s1 = s0;
                if (dorope) { const PG8_LAS float* rp = rope + p * 16 + 8 * (fq & 1); c0 = *(const PG8_LAS f32x4*)rp; c1 = *(const PG8_LAS f32x4*)(rp + 4); s0 = *(const PG8_LAS f32x4*)(rp + 1024); s1 = *(const PG8_LAS f32x4*)(rp + 1028); }
#pragma unroll
                for (int bj = 0; bj < 2; ++bj) {
                    const int colw = u.pn * BM + bj * HALF + wc * 32;
                    const f32x2 rs2 = {rstd, rstd};
                    f32x2 v[4];
#pragma unroll
                    for (int n = 0; n < 2; ++n)
#pragma unroll
                        for (int q = 0; q < 2; ++q) v[2 * n + q] = __builtin_elementwise_fma((f32x2){acc[ai][bj][m][n][2 * q], acc[ai][bj][m][n][2 * q + 1]}, rs2, (f32x2){bv[bj][n][2 * q], bv[bj][n][2 * q + 1]});
                    if (dorope && colw < 640) {
                        const f32x2 sg2 = {sgn, sgn};
#pragma unroll
                        for (int k = 0; k < 4; ++k) { f32x2 p; p.x = __shfl_xor(v[k].x, 32); p.y = __shfl_xor(v[k].y, 32);
                            const f32x4 cc = (k < 2) ? c0 : c1, sn = (k < 2) ? s0 : s1;
                            const f32x2 c2 = {cc[2 * (k & 1)], cc[2 * (k & 1) + 1]}, s2 = {sn[2 * (k & 1)], sn[2 * (k & 1) + 1]};
                            v[k] = __builtin_elementwise_fma(v[k], c2, (p * s2) * sg2); }
                    }
                    if (colw < 512) { const f32x2 qs2 = {QSCALE, QSCALE};
#pragma unroll
                        for (int k = 0; k < 4; ++k) v[k] = v[k] * qs2; }
                    u32x4 w; w.x = cvt_pk_bf16(v[0].x, v[0].y); w.y = cvt_pk_bf16(v[1].x, v[1].y); w.z = cvt_pk_bf16(v[2].x, v[2].y); w.w = cvt_pk_bf16(v[3].x, v[3].y);
                    *(u32x4*)(U + (size_t)row * 1536 + colw + 8 * fq) = w;
                }
            }
            asm volatile("" ::: "memory");
        }
    }
};
typedef unsigned u32x2 __attribute__((ext_vector_type(2)));
#ifndef EPI_DEPTH
#define EPI_DEPTH 1
#endif
struct EpiResid {
    static constexpr bool PERM = false, AFTER_DRAIN = false;
    const float* srcL; const float* srcC; float* dst; const float* gate;
    bf16_t* hb; float* ss; const float* ng; const float* nsc;
    PG8_LAS unsigned char* xp;
    __device__ __forceinline__ void operator()(const f32x4 (&acc)[2][2][4][2], const Unit& u, int wr, int wc, int fr, int fq) const {
        const bool latent = u.pm < 256;
        const int mrow = latent ? (u.pm >> 3) : 32;
        const int col0 = u.pn * BM + wc * 32 + 4 * fq;
        const float* gp = gate + (size_t)mrow * 12288 + col0;
        f32x4 gv[2][2];
#pragma unroll
        for (int bj = 0; bj < 2; ++bj)
#pragma unroll
            for (int n = 0; n < 2; ++n) gv[bj][n] = *(const f32x4*)(gp + bj * HALF + n * 16);
        f32x4 wn[2][2];
        if (hb) {
#pragma unroll
            for (int bj = 0; bj < 2; ++bj)
#pragma unroll
                for (int n = 0; n < 2; ++n) wn[bj][n] = *(const f32x4*)(ng + col0 + bj * HALF + n * 16) * (*(const f32x4*)(nsc + (size_t)mrow * 12288 + col0 + bj * HALF + n * 16) + 1.0f);
        }
        const int row0 = u.pm * BM + wr * 64 + fr;
        const float* src = latent ? srcL : (srcC - (size_t)65536 * 1024);
        const int l = fq * 16 + fr;
        PG8_LAS float* T = (PG8_LAS float*)(xp + (wr * 4 + wc) * 2304);
        PG8_LAS unsigned char* Tb = xp + (wr * 4 + wc) * 2304;
        constexpr int DEPTH = EPI_DEPTH;
        f32x4 rw[8][2][2];
#define EPI_LOAD(g_) do { const float* sp_ = src + (size_t)(u.pm * BM + ((g_) >> 2) * HALF + wr * 64 + ((g_) & 3) * 16 + (l >> 3)) * 1024 + u.pn * BM + wc * 32 + 4 * (l & 7); \
            _Pragma("unroll") for (int bj = 0; bj < 2; ++bj) { rw[g_][bj][0] = *(const f32x4*)(sp_ + bj * HALF); rw[g_][bj][1] = *(const f32x4*)(sp_ + bj * HALF + 8 * 1024); } } while (0)
#pragma unroll
        for (int g = 0; g < DEPTH; ++g) EPI_LOAD(g);
#pragma unroll
        for (int g = 0; g < 8; ++g) {
            const int ai = g >> 2, m = g & 3;
            f32x2 s2 = {0.f, 0.f};
            f32x4 o[2][2];
#pragma unroll
            for (int bj = 0; bj < 2; ++bj) {
                *(PG8_LAS f32x4*)(T + (l >> 3) * 36 + 4 * (l & 7)) = rw[g][bj][0]; *(PG8_LAS f32x4*)(T + (8 + (l >> 3)) * 36 + 4 * (l & 7)) = rw[g][bj][1];
                asm volatile("" ::: "memory");
                const f32x4 r0 = *(const PG8_LAS f32x4*)(T + fr * 36 + 4 * fq), r1 = *(const PG8_LAS f32x4*)(T + fr * 36 + 16 + 4 * fq);
                asm volatile("" ::: "memory");
#pragma unroll
                for (int n = 0; n < 2; ++n) { const f32x4 rr = n ? r1 : r0, gg = gv[bj][n], aa = acc[ai][bj][m][n];
                    const f32x2 ol = __builtin_elementwise_fma((f32x2){gg[0], gg[1]}, (f32x2){aa[0], aa[1]}, (f32x2){rr[0], rr[1]}), oh = __builtin_elementwise_fma((f32x2){gg[2], gg[3]}, (f32x2){aa[2], aa[3]}, (f32x2){rr[2], rr[3]});
                    o[bj][n] = (f32x4){ol.x, ol.y, oh.x, oh.y};
                    s2 = __builtin_elementwise_fma(ol, ol, s2); s2 = __builtin_elementwise_fma(oh, oh, s2); }
            }
            asm volatile("" ::: "memory");
            if (g + DEPTH < 8) EPI_LOAD(g + DEPTH);
            asm volatile("" ::: "memory");
            const size_t tbase = (size_t)(u.pm * BM + ai * HALF + wr * 64 + m * 16) * 1024 + u.pn * BM + wc * 32;
#pragma unroll
            for (int bj = 0; bj < 2; ++bj) {
                *(PG8_LAS f32x4*)(T + fr * 36 + 4 * fq) = o[bj][0]; *(PG8_LAS f32x4*)(T + fr * 36 + 16 + 4 * fq) = o[bj][1];
                asm volatile("" ::: "memory");
                const f32x4 a0 = *(const PG8_LAS f32x4*)(T + (l >> 3) * 36 + 4 * (l & 7)), a1 = *(const PG8_LAS f32x4*)(T + (8 + (l >> 3)) * 36 + 4 * (l & 7));
                asm volatile("" ::: "memory");
                float* dp = dst + tbase + bj * HALF + (size_t)(l >> 3) * 1024 + 4 * (l & 7);
                *(f32x4*)dp = a0; *(f32x4*)(dp + 8 * 1024) = a1;
                if (hb) { const f32x2 y0l = (f32x2){o[bj][0][0], o[bj][0][1]} * (f32x2){wn[bj][0][0], wn[bj][0][1]}, y0h = (f32x2){o[bj][0][2], o[bj][0][3]} * (f32x2){wn[bj][0][2], wn[bj][0][3]};
                    const f32x2 y1l = (f32x2){o[bj][1][0], o[bj][1][1]} * (f32x2){wn[bj][1][0], wn[bj][1][1]}, y1h = (f32x2){o[bj][1][2], o[bj][1][3]} * (f32x2){wn[bj][1][2], wn[bj][1][3]};
                    u32x2 w0, w1; w0.x = cvt_pk_bf16(y0l.x, y0l.y); w0.y = cvt_pk_bf16(y0h.x, y0h.y); w1.x = cvt_pk_bf16(y1l.x, y1l.y); w1.y = cvt_pk_bf16(y1h.x, y1h.y);
                    *(PG8_LAS u32x2*)(Tb + fr * 80 + 8 * fq) = w0; *(PG8_LAS u32x2*)(Tb + fr * 80 + 32 + 8 * fq) = w1;
                    asm volatile("" ::: "memory");
                    const u32x4 hv = *(const PG8_LAS u32x4*)(Tb + (l >> 2) * 80 + 16 * (l & 3));
                    asm volatile("" ::: "memory");
                    *(u32x4*)(hb + tbase + bj * HALF + (size_t)(l >> 2) * 1024 + 8 * (l & 3)) = hv; }
            }
            float s = s2.x + s2.y;
            s += __shfl_xor(s, 16); s += __shfl_xor(s, 32);
            if (fq == 0) ss[(size_t)(u.pn * 4 + wc) * SS_LD + row0 + ai * HALF + m * 16] = s;
        }
#undef EPI_LOAD
    }
};
struct EpiSwiGLU {
    static constexpr bool PERM = true, AFTER_DRAIN = false;
    bf16_t* O; const float* ss; const float* bias;
    PG8_LAS float* rl;
    __device__ __forceinline__ void operator()(const f32x4 (&acc)[2][2][4][2], const Unit& u, int wr, int wc, int fr, int fq) const {
        const int row0 = u.pm * BM + wr * 64 + fr; const int col0 = u.pn * HALF + wc * 32 + 8 * fq;
        f32x4 bv[2][2];
        { const float* bp = bias + (size_t)(u.pm < 256 ? (u.pm >> 3) : 32) * 5632 + u.pn * BM + wc * 32 + 8 * fq;
#pragma unroll
          for (int bj = 0; bj < 2; ++bj)
#pragma unroll
              for (int n = 0; n < 2; ++n) bv[bj][n] = *(const f32x4*)(bp + bj * HALF + 4 * n); }
        { const int wid = wr * 4 + wc, l = fq * 16 + fr;
          const float* p = ss + (size_t)(8 * (l >> 5)) * SS_LD + u.pm * BM + 32 * wid + (l & 31);
          float s = ((p[0] + p[SS_LD]) + (p[2 * SS_LD] + p[3 * SS_LD])) + ((p[4 * SS_LD] + p[5 * SS_LD]) + (p[6 * SS_LD] + p[7 * SS_LD]));
          s += __shfl_xor(s, 32);
          if (l < 32) rl[32 * wid + l] = __builtin_amdgcn_rsqf(s * (1.0f / 1024.0f) + 1e-6f); }
        asm volatile("s_waitcnt lgkmcnt(0)" ::: "memory"); __builtin_amdgcn_s_barrier(); asm volatile("" ::: "memory");
        float rs[2][4];
#pragma unroll
        for (int ai = 0; ai < 2; ++ai)
#pragma unroll
            for (int m = 0; m < 4; ++m) rs[ai][m] = rl[ai * HALF + wr * 64 + m * 16 + fr];
        asm volatile("" ::: "memory");
#pragma unroll
        for (int ai = 0; ai < 2; ++ai)
#pragma unroll
            for (int m = 0; m < 4; ++m) {
                const f32x2 rs2 = {rs[ai][m], rs[ai][m]}; const f32x2 one2 = {1.0f, 1.0f};
                f32x2 hp[4];
#pragma unroll
                for (int n = 0; n < 2; ++n)
#pragma unroll
                    for (int q = 0; q < 2; ++q) {
                        const f32x2 ag = {acc[ai][0][m][n][2 * q], acc[ai][0][m][n][2 * q + 1]}, au = {acc[ai][1][m][n][2 * q], acc[ai][1][m][n][2 * q + 1]};
                        const f32x2 bg = {bv[0][n][2 * q], bv[0][n][2 * q + 1]}, bu = {bv[1][n][2 * q], bv[1][n][2 * q + 1]};
                        const f32x2 g = __builtin_elementwise_fma(ag, rs2, bg), uu = __builtin_elementwise_fma(au, rs2, bu);
                        f32x2 ex; ex.x = __builtin_amdgcn_exp2f(g.x); ex.y = __builtin_amdgcn_exp2f(g.y);
                        const f32x2 d = ex + one2; f32x2 r; r.x = __builtin_amdgcn_rcpf(d.x); r.y = __builtin_amdgcn_rcpf(d.y);
                        hp[2 * n + q] = (g * uu) * r; }
                u32x4 w; w.x = cvt_pk_bf16(hp[0].x, hp[0].y); w.y = cvt_pk_bf16(hp[1].x, hp[1].y); w.z = cvt_pk_bf16(hp[2].x, hp[2].y); w.w = cvt_pk_bf16(hp[3].x, hp[3].y);
                *(u32x4*)(O + (size_t)(row0 + ai * HALF + m * 16) * 2816 + col0) = w;
            }
    }
};
struct EpiMod {
    static constexpr bool PERM = false, AFTER_DRAIN = false;
    float* out; const float* bias; bf16_t* ash;
    __device__ __forceinline__ void operator()(const f32x4 (&acc)[2][2][4][2], const Unit& u, int wr, int wc, int fr, int fq) const {
        if (wr != 0) return;
        const int col0 = u.pn * BM + wc * 32 + 4 * fq;
#pragma unroll
        for (int m = 0; m < 3; ++m) { const int row = m * 16 + fr;
            if (row < 33) {
#pragma unroll
                for (int bj = 0; bj < 2; ++bj)
#pragma unroll
                    for (int n = 0; n < 2; ++n) { const int c = col0 + bj * HALF + n * 16; const f32x4 v = acc[0][bj][m][n] + *(const f32x4*)(bias + c); *(f32x4*)(out + (size_t)row * 12288 + c) = v;
                        const int l = c / 6144, q = (c % 6144) >> 10;
                        if (q == 0 || q == 3) { u32x2 w; w.x = cvt_pk_bf16(v[0], v[1]); w.y = cvt_pk_bf16(v[2], v[3]); *(u32x2*)(ash + (size_t)(l * 2 + (q == 3)) * 256 * 1024 + (size_t)row * 1024 + (c & 1023)) = w; } }
            } }
    }
};
struct EpiBias {
    static constexpr bool PERM = true, AFTER_DRAIN = false;
    float* out; int ldo;
    __device__ __forceinline__ void operator()(const f32x4 (&acc)[2][2][4][2], const Unit& u, int wr, int wc, int fr, int fq) const {
        if (wr != 0) return;
        const int col0 = u.pn * BM + wc * 32 + 8 * fq;
#pragma unroll
        for (int m = 0; m < 3; ++m) { const int row = m * 16 + fr;
            if (row < 33) {
#pragma unroll
                for (int bj = 0; bj < 2; ++bj)
#pragma unroll
                    for (int n = 0; n < 2; ++n) *(f32x4*)(out + (size_t)row * ldo + col0 + bj * HALF + n * 4) = acc[0][bj][m][n];
            } }
    }
};
struct SchedOne {
    int pn; bool on;
    __device__ bool next(int i, Unit& u) const { if (i != 0 || !on) return false; u.pm = 0; u.pn = pn; return true; }
    __device__ __forceinline__ void a_ready(const Unit&) const {}
    __device__ __forceinline__ void done(const Unit&) const {}
};
struct SchedMod {
    int c;
    __device__ bool next(int i, Unit& u) const { if (i != 0 || c >= 48) return false; u.pm = 0; u.pn = c; return true; }
    __device__ __forceinline__ void a_ready(const Unit&) const {}
    __device__ __forceinline__ void done(const Unit&) const {}
};
template <class Epi, class Sched, bool ALIGN_EPI = false, bool SP2 = false>
__device__ __forceinline__ void gemm_phase(PG8_LAS unsigned char* lds, const Gemm g, const Sched& S, const Epi& E) {
    int tid_ = threadIdx.x; asm volatile("" : "+v"(tid_));
    const int tid = tid_, wid = __builtin_amdgcn_readfirstlane(tid >> 6), lane = tid & 63, wr = wid >> 2, wc = wid & 3, fr = lane & 15, fq = lane >> 4;
    const int K = g.K, nt = K / BK;
    unsigned voffA[2], voffB[2];
#pragma unroll
    for (int i = 0; i < 2; ++i) { int R, C; stage_rc(tid * 16 + i * 8192, R, C); const int Rb = Epi::PERM ? ((R & ~31) + perm32(R & 31)) : R;
        voffA[i] = (unsigned)(R * K + C) * 2u; voffB[i] = (unsigned)(tid * 16 + i * 8192); (void)Rb; }
    const size_t kstep = (size_t)(BK * 2);
    const size_t hstep = (size_t)HALF * K * 2;
    const size_t tstep = 2 * hstep;
    const size_t kstepB = 32768, hstepB = 16384;
    const unsigned ldsw = (unsigned)wid * 1024u;
    const int aoff = lds_byte(wr * 64 + fr, fq * 8), boff = lds_byte(wc * 32 + fr, fq * 8);
#define PG8_SA(b, h) (((b) * 2 + (h)) * HTB)
#define PG8_SB(b, h) ((4 + (b) * 2 + (h)) * HTB)
#define PG8_STAGE(bufoff, gbase, voff) do { _Pragma("unroll") for (int _i = 0; _i < 2; ++_i) \
        __builtin_amdgcn_global_load_lds((const unsigned*)((const char*)(gbase) + (voff)[_i]), (PG8_LAS unsigned*)(lds + (bufoff) + ldsw + _i * 8192), 16, 0, 0); } while (0)
#define PG8_LDA(dst, b, h) do { _Pragma("unroll") for (int m = 0; m < 4; ++m) _Pragma("unroll") for (int k = 0; k < 2; ++k) dst[m][k] = *(const PG8_LAS bf16x8*)(lds + PG8_SA(b, h) + aoff + m * 2048 + k * 1024); } while (0)
#define PG8_LDB(dst, b, h) do { _Pragma("unroll") for (int n = 0; n < 2; ++n) _Pragma("unroll") for (int k = 0; k < 2; ++k) dst[n][k] = *(const PG8_LAS bf16x8*)(lds + PG8_SB(b, h) + boff + n * 2048 + k * 1024); } while (0)
#define PG8_MMA(ai, bj, At, Bt) do { __builtin_amdgcn_s_setprio(1); _Pragma("unroll") for (int m = 0; m < 4; ++m) _Pragma("unroll") for (int n = 0; n < 2; ++n) _Pragma("unroll") for (int k = 0; k < 2; ++k) \
        acc[ai][bj][m][n] = __builtin_amdgcn_mfma_f32_16x16x32_bf16(Bt[n][k], At[m][k], acc[ai][bj][m][n], 0, 0, 0); __builtin_amdgcn_s_setprio(0); } while (0)
#define PG8_WAIT_V(n) asm volatile("s_waitcnt vmcnt(" #n ")" ::: "memory")
#define PG8_WAIT_L(n) asm volatile("s_waitcnt lgkmcnt(" #n ")" ::: "memory")
#define PG8_BAR __builtin_amdgcn_s_barrier()
#define PG8_SCHED __builtin_amdgcn_sched_barrier(0)
    Unit cur, nxt; int ui = 0;
    if (!S.next(0, cur)) return;
    f32x4 acc[2][2][4][2];
#pragma unroll
    for (int a = 0; a < 2; ++a)
#pragma unroll
        for (int b = 0; b < 2; ++b)
#pragma unroll
            for (int m = 0; m < 4; ++m)
#pragma unroll
                for (int n = 0; n < 2; ++n) acc[a][b][m][n] = (f32x4){0.f, 0.f, 0.f, 0.f};
    bf16x8 At[4][2], B0[2][2], B1[2][2];
    const char* cA = (const char*)g.A + (size_t)cur.pm * tstep; const char* cB = (const char*)g.Bt + (size_t)cur.pn * tstep;
    S.a_ready(cur);
    if constexpr (SP2) {
        PG8_STAGE(PG8_SB(0, 0), cB, voffB); PG8_STAGE(PG8_SB(0, 1), cB + hstepB, voffB); PG8_STAGE(PG8_SA(0, 0), cA, voffA); PG8_STAGE(PG8_SA(0, 1), cA + hstep, voffA);
        if (wr == 1) PG8_BAR;
        PG8_WAIT_V(2); PG8_BAR;
        PG8_STAGE(PG8_SB(1, 0), cB + kstepB, voffB); PG8_STAGE(PG8_SA(1, 0), cA + kstep, voffA); PG8_STAGE(PG8_SB(1, 1), cB + hstepB + kstepB, voffB);
        PG8_WAIT_V(6); PG8_BAR;
    } else {
        PG8_STAGE(PG8_SB(0, 0), cB, voffB); PG8_STAGE(PG8_SA(0, 0), cA, voffA); PG8_STAGE(PG8_SB(0, 1), cB + hstepB, voffB); PG8_STAGE(PG8_SA(0, 1), cA + hstep, voffA);
        if (wr == 1) PG8_BAR;
        PG8_WAIT_V(4); PG8_BAR;
        PG8_STAGE(PG8_SB(1, 0), cB + kstepB, voffB); PG8_STAGE(PG8_SA(1, 0), cA + kstep, voffA); PG8_STAGE(PG8_SB(1, 1), cB + hstepB + kstepB, voffB);
        PG8_WAIT_V(6); PG8_BAR;
    }
    for (;;) {
        const bool has_next = S.next(ui + 1, nxt);
        const char* nA = has_next ? (const char*)g.A + (size_t)nxt.pm * tstep : cA; const char* nB = has_next ? (const char*)g.Bt + (size_t)nxt.pn * tstep : cB;
        for (int t = 0; t < nt; t += 2) {
            const bool last = (t == nt - 2);
            const char* a1 = cA + (size_t)(t + 1) * kstep;
            const char* a2 = last ? nA : cA + (size_t)(t + 2) * kstep; const char* b2 = last ? nB : cB + (size_t)(t + 2) * kstepB;
            const char* a3 = a2 + kstep; const char* b3 = b2 + kstepB;
            if (last && has_next) S.a_ready(nxt);
            if constexpr (SP2) {
            PG8_LDB(B0, 0, 0); PG8_LDB(B1, 0, 1); PG8_SCHED; PG8_LDA(At, 0, 0); PG8_STAGE(PG8_SA(1, 1), a1 + hstep, voffA);
            PG8_WAIT_V(8); PG8_WAIT_L(0); PG8_BAR; PG8_MMA(0, 0, At, B0); PG8_MMA(0, 1, At, B1); PG8_BAR; PG8_SCHED;
            PG8_LDA(At, 0, 1); PG8_STAGE(PG8_SB(0, 0), b2, voffB); PG8_STAGE(PG8_SB(0, 1), b2 + hstepB, voffB); PG8_STAGE(PG8_SA(0, 0), a2, voffA);
            PG8_WAIT_V(8); PG8_WAIT_L(0); PG8_BAR; PG8_MMA(1, 0, At, B0); PG8_MMA(1, 1, At, B1); PG8_BAR; PG8_SCHED;
            PG8_LDB(B0, 1, 0); PG8_LDB(B1, 1, 1); PG8_SCHED; PG8_LDA(At, 1, 0); PG8_STAGE(PG8_SA(0, 1), a2 + hstep, voffA);
            PG8_WAIT_V(8); PG8_WAIT_L(0); PG8_BAR; PG8_MMA(0, 0, At, B0); PG8_MMA(0, 1, At, B1); PG8_BAR; PG8_SCHED;
            PG8_LDA(At, 1, 1); PG8_STAGE(PG8_SB(1, 0), b3, voffB); PG8_STAGE(PG8_SB(1, 1), b3 + hstepB, voffB); PG8_STAGE(PG8_SA(1, 0), a3, voffA);
            PG8_WAIT_V(8); PG8_WAIT_L(0); PG8_BAR; PG8_MMA(1, 0, At, B0); PG8_MMA(1, 1, At, B1); PG8_BAR; PG8_SCHED;
            } else {
            PG8_LDB(B0, 0, 0); PG8_SCHED; PG8_LDA(At, 0, 0); PG8_STAGE(PG8_SA(1, 1), a1 + hstep, voffA);
            PG8_WAIT_L(8); PG8_BAR; PG8_WAIT_L(0); PG8_MMA(0, 0, At, B0); PG8_BAR; PG8_SCHED;
            PG8_LDB(B1, 0, 1); PG8_STAGE(PG8_SB(0, 0), b2, voffB);
            PG8_BAR; PG8_WAIT_L(0); PG8_MMA(0, 1, At, B1); PG8_BAR;
            PG8_LDA(At, 0, 1); PG8_STAGE(PG8_SA(0, 0), a2, voffA);
            PG8_BAR; PG8_WAIT_L(0); PG8_MMA(1, 0, At, B0); PG8_BAR; PG8_SCHED;
            PG8_STAGE(PG8_SB(0, 1), b2 + hstepB, voffB);
            PG8_WAIT_V(6); PG8_BAR; PG8_MMA(1, 1, At, B1); PG8_BAR;
            PG8_LDB(B0, 1, 0); PG8_SCHED; PG8_LDA(At, 1, 0); PG8_STAGE(PG8_SA(0, 1), a2 + hstep, voffA);
            PG8_WAIT_L(8); PG8_BAR; PG8_WAIT_L(0); PG8_MMA(0, 0, At, B0); PG8_BAR; PG8_SCHED;
            PG8_LDB(B1, 1, 1); PG8_STAGE(PG8_SB(1, 0), b3, voffB);
            PG8_BAR; PG8_WAIT_L(0); PG8_MMA(0, 1, At, B1); PG8_BAR;
            PG8_LDA(At, 1, 1); PG8_STAGE(PG8_SA(1, 0), a3, voffA);
            PG8_BAR; PG8_WAIT_L(0); PG8_MMA(1, 0, At, B0); PG8_BAR; PG8_SCHED;
            PG8_STAGE(PG8_SB(1, 1), b3 + hstepB, voffB);
            PG8_WAIT_V(6); PG8_BAR; PG8_MMA(1, 1, At, B1); PG8_BAR;
            }
        }
        if constexpr (ALIGN_EPI) { if (wr == 0) PG8_BAR; }
        if constexpr (!Epi::AFTER_DRAIN) { E(acc, cur, wr, wc, fr, fq); S.done(cur); }
        if (!has_next) break;
#pragma unroll
        for (int a = 0; a < 2; ++a)
#pragma unroll
            for (int b = 0; b < 2; ++b)
#pragma unroll
                for (int m = 0; m < 4; ++m)
#pragma unroll
                    for (int n = 0; n < 2; ++n) acc[a][b][m][n] = (f32x4){0.f, 0.f, 0.f, 0.f};
        cur = nxt; cA = nA; cB = nB; ++ui;
        if constexpr (ALIGN_EPI) { if (wr == 1) PG8_BAR; }
    }
    PG8_WAIT_V(0);
    if constexpr (!ALIGN_EPI) { if (wr == 0) PG8_BAR; }
    PG8_BAR;
    if constexpr (Epi::AFTER_DRAIN) { E.fused(acc, cur, wr, wc, fr, fq, lds, wid, lane); S.done(cur); }
#undef PG8_SA
#undef PG8_SB
#undef PG8_STAGE
#undef PG8_LDA
#undef PG8_LDB
#undef PG8_MMA
#undef PG8_WAIT_V
#undef PG8_WAIT_L
#undef PG8_BAR
#undef PG8_SCHED
}
}

constexpr int DM = 1024, NBATCH = 32, SEQ = 2048, NCTX = 256;
constexpr int ML = NBATCH * SEQ, MC = NBATCH * NCTX, MT = ML + MC;
constexpr int INW = 1536, DFF = 2816, NMOD = 6144;
constexpr float EPS = 1e-6f;
constexpr int NWAVES = 8;
#ifndef REP_P0
#define REP_P0 1
#endif
#ifndef REP_ATT
#define REP_ATT 1
#endif
#ifndef REP_G2
#define REP_G2 1
#endif
#ifndef REP_P0C
#define REP_P0C 1
#endif
#ifndef REP_MIX
#define REP_MIX 1
#endif
#ifndef REP_NORM
#define REP_NORM 1
#endif
#ifndef REP_G3
#define REP_G3 1
#endif
#ifndef REP_G1
#define REP_G1 1
#endif
#ifndef MK_SPLIT
#define MK_SPLIT 0
#endif

constexpr size_t MiB = 1u << 20;
constexpr size_t WS_CTL = 0;
constexpr size_t WS_ROPE = 1 * MiB, WS_MOD = 2 * MiB, WS_AMOD = 4 * MiB, WS_WMODT = 8 * MiB, WS_WINT = 32 * MiB, WS_WOUTT = 38 * MiB, WS_WF1T = 42 * MiB, WS_WF2T = 64 * MiB;
constexpr size_t WS_XS = 80 * MiB, WS_H = 368 * MiB, WS_U = 512 * MiB, WS_CAT = 728 * MiB, WS_ACT = 512 * MiB, WS_SS = 908 * MiB, WS_END = 916 * MiB;
constexpr size_t WS_ASH = 5 * MiB, WS_BIAS1 = 7 * MiB, WS_BIAS2 = 75 * MiB;
static_assert(WS_XS + (size_t)MT * DM * 4 <= WS_H && WS_H + (size_t)MT * DM * 2 <= WS_U && WS_U + (size_t)MT * INW * 2 <= WS_CAT && WS_CAT + (size_t)MT * DM * 2 <= WS_SS && WS_ACT + (size_t)MT * DFF * 2 <= WS_SS && WS_SS + (size_t)MT * 64 <= WS_END && WS_BIAS2 + (size_t)2 * 33 * 5632 * 4 <= WS_XS, "ws map");
static_assert(WS_WF2T + (size_t)2 * DM * DFF * 2 <= WS_XS && WS_WF1T + (size_t)2 * 2 * DFF * DM * 2 <= WS_WF2T && WS_WMODT + (size_t)2 * NMOD * DM * 2 <= WS_WINT, "ws map (weights)");

constexpr int RING_BYTES = 131072, LDS_BYTES = 163840, ROPE_LDS = RING_BYTES + 1024, XPOSE_LDS = ROPE_LDS + 8192;

static_assert(XPOSE_LDS + 8 * 2304 <= LDS_BYTES, "LDS map");
#define LAS __attribute__((address_space(3)))
typedef unsigned short bf16;
typedef unsigned v4u __attribute__((ext_vector_type(4)));
typedef unsigned v2u __attribute__((ext_vector_type(2)));
typedef float f32x4 __attribute__((ext_vector_type(4)));
typedef float f32x16 __attribute__((ext_vector_type(16)));
typedef short bf16x8 __attribute__((ext_vector_type(8)));
typedef float f32x2_t __attribute__((ext_vector_type(2)));
typedef __bf16 bf16x2_t __attribute__((ext_vector_type(2)));
__device__ __forceinline__ unsigned pk2(float lo, float hi) { f32x2_t v = {lo, hi}; bf16x2_t b = __builtin_convertvector(v, bf16x2_t); return __builtin_bit_cast(unsigned, b); }
__device__ __forceinline__ float bflo(unsigned w) { return __uint_as_float(w << 16); }
__device__ __forceinline__ float bfhi(unsigned w) { return __uint_as_float(w & 0xffff0000u); }
__device__ __forceinline__ float wave_sum(float v) { return pg8::xadd32(pg8::xadd16(pg8::row16_sum(v))); }
__device__ __forceinline__ float silu_f(float v) { return v * __builtin_amdgcn_rcpf(1.0f + __builtin_amdgcn_exp2f(v * -1.4426950408889634f)); }

struct Params {
    const float *x, *c, *ctx, *c_ctx, *w_mod, *b_mod, *n1g, *n2g, *w_in, *cdw, *cdwb, *clng, *clnb, *sink, *poolw, *pools, *w_out, *wf1, *wf2, *fing;
    float* out; unsigned char* ws;
    int ph_lo, ph_hi;
};

__device__ __forceinline__ size_t wimg_off(int row, int k, int K, bool perm) {
    const int r128 = row & 127; const int cc = r128 & 31;
    const int R = perm ? ((r128 & ~31) + 16 * ((cc >> 2) & 1) + 4 * (cc >> 3) + (cc & 3)) : r128;
    return ((size_t)((row >> 8) * (K >> 6) + (k >> 6)) * 32768 + (size_t)((row >> 7) & 1) * 16384 + (size_t)pg8::lds_byte(R, k & 63)) >> 1;
}
__device__ __forceinline__ void tr_item(const float* W, int ldw, bf16* WT, int ldt, int k0, int n0, int drow0, LAS float* scr, int lane, bool perm, float wscale = 1.0f) {
    { f32x4 wv[8];
#pragma unroll
      for (int i = 0; i < 8; ++i) wv[i] = *(const f32x4*)(W + (size_t)(k0 + 8 * i + (lane >> 3)) * ldw + n0 + 4 * (lane & 7));
#pragma unroll
      for (int i = 0; i < 8; ++i) { LAS float* d = scr + (8 * i + (lane >> 3)) * 33 + 4 * (lane & 7); d[0] = wv[i].x; d[1] = wv[i].y; d[2] = wv[i].z; d[3] = wv[i].w; } }
    asm volatile("s_waitcnt lgkmcnt(0)" ::: "memory");
    const int c = lane & 7;
#pragma unroll
    for (int j = 0; j < 4; ++j) { const int n = (lane >> 3) + 8 * j; const LAS float* s = scr + (8 * c) * 33 + n;
        v4u o; o.x = pk2(s[0 * 33] * wscale, s[1 * 33] * wscale); o.y = pk2(s[2 * 33] * wscale, s[3 * 33] * wscale); o.z = pk2(s[4 * 33] * wscale, s[5 * 33] * wscale); o.w = pk2(s[6 * 33] * wscale, s[7 * 33] * wscale);
        *(v4u*)(WT + wimg_off(drow0 + n, k0 + 8 * c, ldt, perm)) = o; }
    asm volatile("s_waitcnt lgkmcnt(0)" ::: "memory");
}
__device__ __forceinline__ void fold_item(const float* wout, const float* pw, const float* ps, bf16* WoutT, int g, int nc, int lane) {
    const int n = nc * 64 + lane;
    float w[64];
#pragma unroll
    for (int d = 0; d < 64; ++d) w[d] = wout[(size_t)(768 + 64 * g + d) * 1024 + n] * ps[64 * g + d];
    const float* pg = pw + (size_t)g * 4096;
    for (int c8 = 0; c8 < 8; ++c8) {
        float a[8];
#pragma unroll
        for (int cc = 0; cc < 8; ++cc) { const float* pr = pg + (c8 * 8 + cc) * 64; float s = 0.f;
#pragma unroll
            for (int d = 0; d < 64; ++d) s = fmaf(pr[d], w[d], s);
            a[cc] = s; }
        v4u o; o.x = pk2(a[0], a[1]); o.y = pk2(a[2], a[3]); o.z = pk2(a[4], a[5]); o.w = pk2(a[6], a[7]);
        *(v4u*)(WoutT + wimg_off(n, 768 + 64 * g + c8 * 8, 1024, false)) = o;
    }
}

__device__ __forceinline__ void phase_p0a(const Params& P, LAS unsigned char* lds, int G, int tid, int wave, int lane) {
    unsigned char* ws = P.ws;
    LAS float* scr = (LAS float*)(lds + wave * 16384);
    const int gw = blockIdx.x * NWAVES + wave, NGW = G * NWAVES;
    bf16* WmodT = (bf16*)(ws + WS_WMODT);
    for (int it = gw; it < 2 * 3072; it += NGW) { const int l = it / 3072, r = it % 3072, kb = r / 192, nb = r % 192;
        tr_item(P.w_mod + (size_t)l * 1024 * NMOD, NMOD, WmodT, 1024, 64 * kb, 32 * nb, l * NMOD + 32 * nb, scr, lane, false); }
    const int gt = blockIdx.x * 512 + tid, GT = G * 512;
    bf16* Amod = (bf16*)(ws + WS_AMOD);
    for (int i = gt; i < 256 * 128; i += GT) { const int row = i >> 7, c8 = (i & 127) * 8; v4u o = {0u, 0u, 0u, 0u};
        if (row < 33) { const float* s = (row < 32 ? P.c + (size_t)row * 1024 : P.c_ctx) + c8; const f32x4 a = *(const f32x4*)s, b = *(const f32x4*)(s + 4);
            o.x = pk2(silu_f(a[0]), silu_f(a[1])); o.y = pk2(silu_f(a[2]), silu_f(a[3])); o.z = pk2(silu_f(b[0]), silu_f(b[1])); o.w = pk2(silu_f(b[2]), silu_f(b[3])); }
        *(v4u*)(Amod + (size_t)row * 1024 + c8) = o; }
    float* rope = (float*)(ws + WS_ROPE);
    if (gt < 1024) { const int p = gt >> 4, i = gt & 15; const float inv = powf(10000.0f, -(float)(2 * i) / 32.0f); const float ang = (float)p * inv; float sn, cs; sincosf(ang, &sn, &cs); rope[gt] = cs; rope[1024 + gt] = sn; }
}
__device__ __forceinline__ void phase_p0b_convert(const Params& P, LAS unsigned char* lds, int G, int wave, int lane) {
    unsigned char* ws = P.ws;
    LAS float* scr = (LAS float*)(lds + wave * 16384);
    const int gw = ((int)blockIdx.x - 48) * NWAVES + wave, NGW = (G - 48) * NWAVES;
    constexpr int I_IN = 16 * 48, I_OUT = 12 * 32, I_F1 = 16 * 176, I_F2 = 44 * 32, I_FOLD = 64, I_L = I_IN + I_OUT + I_F1 + I_F2 + I_FOLD;
    for (int it = gw; it < 2 * I_L; it += NGW) {
        const int l = it / I_L; int r = it % I_L;
        if (r < I_FOLD) { fold_item(P.w_out + (size_t)l * 1024 * 1024, P.poolw + (size_t)l * 4 * 4096, P.pools + l * 256, (bf16*)(ws + WS_WOUTT) + (size_t)l * 1024 * 1024, r >> 4, r & 15, lane); continue; } r -= I_FOLD;
        if (r < I_IN) { const int kb = r / 48, nb = r % 48; const int n0 = 32 * nb; int drow = n0;
            if (n0 >= 768 && n0 < 1280) { const int isg = n0 >= 1024; const int ii = n0 - 768 - 256 * isg; drow = 768 + 256 * (ii >> 7) + 128 * isg + (ii & 127); }
            tr_item(P.w_in + (size_t)l * 1024 * INW, INW, (bf16*)(ws + WS_WINT) + (size_t)l * INW * 1024, 1024, 64 * kb, n0, drow, scr, lane, true); continue; } r -= I_IN;
        if (r < I_OUT) { const int kb = r / 32, nb = r % 32; tr_item(P.w_out + (size_t)l * 1024 * 1024, 1024, (bf16*)(ws + WS_WOUTT) + (size_t)l * 1024 * 1024, 1024, 64 * kb, 32 * nb, 32 * nb, scr, lane, false); continue; } r -= I_OUT;
        if (r < I_F1) { const int kb = r / 176, nb = r % 176; const int n0 = 32 * nb; const int isu = n0 >= DFF; const int nn = n0 - isu * DFF; const int drow = 256 * (nn / 128) + 128 * isu + (nn % 128);
            tr_item(P.wf1 + (size_t)l * 1024 * 2 * DFF, 2 * DFF, (bf16*)(ws + WS_WF1T) + (size_t)l * 2 * DFF * 1024, 1024, 64 * kb, n0, drow, scr, lane, true, isu ? -0.6931471805599453f : -1.4426950408889634f); continue; } r -= I_F1;
        { const int kb = r / 32, nb = r % 32; tr_item(P.wf2 + (size_t)l * DFF * 1024, 1024, (bf16*)(ws + WS_WF2T) + (size_t)l * 1024 * DFF, DFF, 64 * kb, 32 * nb, 32 * nb, scr, lane, false); }
    }
}

__device__ __forceinline__ void phase_norm0(const float* srcL, const float* srcC, bf16* HB, float* SS, const float* gvec, const float* mod_sc, int q0, int q1, int wave, int lane) {
    for (int q = q0 + wave; q < q1; q += NWAVES) {
        const int row = 4 * q; const bool latent = row < ML; const int mrow = latent ? (row >> 11) : 32;
        const f32x4* xr = (const f32x4*)(latent ? srcL + (size_t)row * DM : srcC + (size_t)(row - ML) * DM) + lane;
        f32x4 v[4][4];
#pragma unroll
        for (int i = 0; i < 4; ++i)
#pragma unroll
            for (int j = 0; j < 4; ++j) v[i][j] = xr[256 * i + 64 * j];
        float s[4];
#pragma unroll
        for (int i = 0; i < 4; ++i) { float a = 0.f;
#pragma unroll
            for (int j = 0; j < 4; ++j) a += (v[i][j].x * v[i][j].x + v[i][j].y * v[i][j].y) + (v[i][j].z * v[i][j].z + v[i][j].w * v[i][j].w);
            s[i] = wave_sum(a); }
        if (lane < 16) *(f32x4*)(SS + (size_t)lane * MT + row) = (lane == 0) ? (f32x4){s[0], s[1], s[2], s[3]} : (f32x4){0.f, 0.f, 0.f, 0.f};
        v2u* o8 = (v2u*)(HB + (size_t)row * DM) + lane;
#pragma unroll
        for (int j = 0; j < 4; ++j) { const int col = 4 * (lane + 64 * j);
            const f32x4 w = *(const f32x4*)(gvec + col) * (*(const f32x4*)(mod_sc + (size_t)mrow * 12288 + col) + 1.0f);
#pragma unroll
            for (int i = 0; i < 4; ++i) { const f32x4 y = v[i][j] * w; v2u o; o.x = pk2(y.x, y.y); o.y = pk2(y.z, y.w); o8[256 * i + 64 * j] = o; } }
    }
}
__device__ __forceinline__ void phase_final(const float* src, const float* SS, float* out, const float* gvec, int G, int wave, int lane) {
    const int gw = blockIdx.x * NWAVES + wave, NGW = G * NWAVES;
    f32x4 g[4];
#pragma unroll
    for (int j = 0; j < 4; ++j) g[j] = *(const f32x4*)(gvec + 4 * (lane + 64 * j));
    for (int row = 4 * gw; row < ML; row += 4 * NGW) {
        const f32x4* xr = (const f32x4*)(src + (size_t)row * DM) + lane;
        f32x4 v[4][4];
#pragma unroll
        for (int i = 0; i < 4; ++i)
#pragma unroll
            for (int j = 0; j < 4; ++j) v[i][j] = xr[256 * i + 64 * j];
        f32x4 t = *(const f32x4*)(SS + (size_t)(lane & 15) * MT + row);
        t.x = pg8::row16_sum(t.x); t.y = pg8::row16_sum(t.y); t.z = pg8::row16_sum(t.z); t.w = pg8::row16_sum(t.w);
        float rr[4];
        rr[0] = rsqrtf(t.x * (1.f / DM) + EPS); rr[1] = rsqrtf(t.y * (1.f / DM) + EPS); rr[2] = rsqrtf(t.z * (1.f / DM) + EPS); rr[3] = rsqrtf(t.w * (1.f / DM) + EPS);
        f32x4* o = (f32x4*)(out + (size_t)row * DM) + lane;
#pragma unroll
        for (int i = 0; i < 4; ++i)
#pragma unroll
            for (int j = 0; j < 4; ++j) o[256 * i + 64 * j] = (v[i][j] * rr[i]) * g[j];
    }
}

constexpr int KV_STRIDE = 144;
constexpr int KV_TILE = 64 * KV_STRIDE;
#define MFMA32(a, b, c) __builtin_amdgcn_mfma_f32_32x32x16_bf16((a), (b), (c), 0, 0, 0)
__device__ __forceinline__ int crow(int r, int h) { return (r & 3) + 8 * (r >> 2) + 4 * h; }
__device__ __forceinline__ void attn_unit(LAS unsigned char* lds, const bf16* U, bf16* CAT, const float* sinkp, int unit, int tid, int wave, int lane) {
    const int r32 = lane & 31, h = lane >> 5;
    int b, kvh, p0, qrow0; bool is_lat;
    if (unit < 1024) { b = unit >> 5; kvh = (unit >> 4) & 1; p0 = (unit & 15) * 128; qrow0 = b * SEQ + p0; is_lat = true; }
    else { const int cu = unit - 1024; b = cu >> 2; kvh = (cu >> 1) & 1; p0 = 0; qrow0 = ML + b * NCTX + (cu & 1) * 128; is_lat = false; }
    const int ctxrow0 = ML + b * NCTX;
    int lt_lo = 0, nt = 4;
    if (is_lat) { lt_lo = (p0 >= 128) ? 0 : 2; const int lt_hi = (p0 + 256 <= SEQ) ? 5 : 3; nt = 4 + lt_hi - lt_lo + 1; }
    const int head = kvh * 4 + (wave >> 1), qbase = 64 * (wave & 1);
    bf16x8 qf[2][4];
#pragma unroll
    for (int rt = 0; rt < 2; ++rt) { const bf16* qp = U + (size_t)(qrow0 + qbase + 32 * rt + r32) * INW + head * 64 + 8 * h;
#pragma unroll
      for (int d0 = 0; d0 < 4; ++d0) qf[rt][d0] = *(const bf16x8*)(qp + 16 * d0); }
    float m_run[2], l_run[2];
    f32x16 o[2][2];
#pragma unroll
    for (int rt = 0; rt < 2; ++rt) { m_run[rt] = sinkp[head] * 1.4426950408889634f; l_run[rt] = (h == 0) ? 1.f : 0.f;
#pragma unroll
      for (int r = 0; r < 16; ++r) { o[rt][0][r] = 0.f; o[rt][1][r] = 0.f; } }
    const int kkey = tid >> 3, kch = tid & 7;
    const int vkey = tid & 63, vch = tid >> 6;
    const int vslot = (vkey & ~15) + 8 * ((vkey >> 2) & 1) + 4 * ((vkey >> 3) & 1) + (vkey & 3);
    LAS unsigned char* Kb = lds; LAS unsigned char* Vb = lds + 2 * KV_TILE;
    const size_t kcol = 512 + kvh * 64 + kch * 8, vcol = 640 + kvh * 64 + vch * 8;
    v4u kreg, vreg;
#define TILE_ROW(t) ((t) < 4 ? ctxrow0 + 64 * (t) : b * SEQ + p0 - 128 + 64 * (lt_lo + (t) - 4))
#define LOAD_TILE(t) do { const int rb_ = TILE_ROW(t); kreg = *(const v4u*)(U + (size_t)(rb_ + kkey) * INW + kcol); vreg = *(const v4u*)(U + (size_t)(rb_ + vkey) * INW + vcol); } while (0)
#define STORE_TILE(buf) do { *(LAS v4u*)(Kb + (buf) * KV_TILE + kkey * KV_STRIDE + kch * 16) = kreg; \
        LAS unsigned short* vp_ = (LAS unsigned short*)(Vb + (buf) * KV_TILE + (vch * 8) * KV_STRIDE + vslot * 2); \
        vp_[0 * (KV_STRIDE / 2)] = (unsigned short)(vreg.x & 0xffffu); vp_[1 * (KV_STRIDE / 2)] = (unsigned short)(vreg.x >> 16); \
        vp_[2 * (KV_STRIDE / 2)] = (unsigned short)(vreg.y & 0xffffu); vp_[3 * (KV_STRIDE / 2)] = (unsigned short)(vreg.y >> 16); \
        vp_[4 * (KV_STRIDE / 2)] = (unsigned short)(vreg.z & 0xffffu); vp_[5 * (KV_STRIDE / 2)] = (unsigned short)(vreg.z >> 16); \
        vp_[6 * (KV_STRIDE / 2)] = (unsigned short)(vreg.w & 0xffffu); vp_[7 * (KV_STRIDE / 2)] = (unsigned short)(vreg.w >> 16); } while (0)
    __syncthreads();
    LOAD_TILE(0); STORE_TILE(0);
    __syncthreads();
    for (int t = 0; t < nt; ++t) {
        const int buf = t & 1;
        if (t + 1 < nt) LOAD_TILE(t + 1);
        const int lt = (t >= 4) ? lt_lo + t - 4 : 2;
        const int off = -128 + 64 * lt;
        const bool skip = (lt == 0 && qbase == 64) || (lt == 5 && qbase == 0);
        if (!skip) {
            const LAS unsigned char* kb = Kb + buf * KV_TILE + r32 * KV_STRIDE + 16 * h;
            const LAS unsigned char* vb = Vb + buf * KV_TILE + r32 * KV_STRIDE + 16 * h;
            f32x16 s[2][2];
#pragma unroll
            for (int rt = 0; rt < 2; ++rt)
#pragma unroll
                for (int r = 0; r < 16; ++r) { s[rt][0][r] = 0.f; s[rt][1][r] = 0.f; }
#pragma unroll
            for (int d0 = 0; d0 < 4; ++d0) {
                const bf16x8 k0 = *(const LAS bf16x8*)(kb + 32 * d0), k1 = *(const LAS bf16x8*)(kb + 32 * KV_STRIDE + 32 * d0);
                s[0][0] = MFMA32(k0, qf[0][d0], s[0][0]); s[0][1] = MFMA32(k1, qf[0][d0], s[0][1]);
                s[1][0] = MFMA32(k0, qf[1][d0], s[1][0]); s[1][1] = MFMA32(k1, qf[1][d0], s[1][1]);
            }
            const bool domask = (t >= 4) && (lt == 0 || lt == 1 || lt == 4 || lt == 5);
            v4u pf[2][4];
#pragma unroll
            for (int rt = 0; rt < 2; ++rt) {
                if (domask) { const int qi = qbase + 32 * rt + r32;
#pragma unroll
                    for (int r = 0; r < 16; ++r) { const int d0_ = crow(r, h) + off - qi, d1_ = d0_ + 32;
                        if (d0_ < -128 || d0_ > 128) s[rt][0][r] = -1e30f; if (d1_ < -128 || d1_ > 128) s[rt][1][r] = -1e30f; } }
                float mx = __builtin_fmaxf(__builtin_fmaxf(s[rt][0][0], s[rt][0][1]), s[rt][1][0]), mx2 = __builtin_fmaxf(__builtin_fmaxf(s[rt][0][2], s[rt][0][3]), s[rt][1][1]);
                mx = __builtin_fmaxf(__builtin_fmaxf(mx, s[rt][1][2]), s[rt][1][3]);
#pragma unroll
                for (int r = 4; r < 16; r += 4) { mx = __builtin_fmaxf(__builtin_fmaxf(mx, s[rt][0][r]), s[rt][0][r + 1]); mx2 = __builtin_fmaxf(__builtin_fmaxf(mx2, s[rt][0][r + 2]), s[rt][0][r + 3]);
                    mx = __builtin_fmaxf(__builtin_fmaxf(mx, s[rt][1][r]), s[rt][1][r + 1]); mx2 = __builtin_fmaxf(__builtin_fmaxf(mx2, s[rt][1][r + 2]), s[rt][1][r + 3]); }
                mx = __builtin_fmaxf(mx, mx2);
                { auto rr = __builtin_amdgcn_permlane32_swap(__float_as_uint(mx), __float_as_uint(mx), false, false); mx = __builtin_fmaxf(__uint_as_float(rr[0]), __uint_as_float(rr[1])); }
                if (__any(mx > m_run[rt] + 8.0f)) {
                    const float m_new = fmaxf(m_run[rt], mx), alpha = __builtin_amdgcn_exp2f(m_run[rt] - m_new);
                    m_run[rt] = m_new; l_run[rt] *= alpha;
#pragma unroll
                    for (int r = 0; r < 16; ++r) { o[rt][0][r] *= alpha; o[rt][1][r] *= alpha; }
                }
                const float m_ref = m_run[rt];
                float ps = 0.f, ps2 = 0.f;
#pragma unroll
                for (int r = 0; r < 16; ++r) { s[rt][0][r] = __builtin_amdgcn_exp2f(s[rt][0][r] - m_ref); s[rt][1][r] = __builtin_amdgcn_exp2f(s[rt][1][r] - m_ref); ps += s[rt][0][r]; ps2 += s[rt][1][r]; }
                l_run[rt] += ps + ps2;
                pf[rt][0] = (v4u){pk2(s[rt][0][0], s[rt][0][1]), pk2(s[rt][0][2], s[rt][0][3]), pk2(s[rt][0][4], s[rt][0][5]), pk2(s[rt][0][6], s[rt][0][7])};
                pf[rt][1] = (v4u){pk2(s[rt][0][8], s[rt][0][9]), pk2(s[rt][0][10], s[rt][0][11]), pk2(s[rt][0][12], s[rt][0][13]), pk2(s[rt][0][14], s[rt][0][15])};
                pf[rt][2] = (v4u){pk2(s[rt][1][0], s[rt][1][1]), pk2(s[rt][1][2], s[rt][1][3]), pk2(s[rt][1][4], s[rt][1][5]), pk2(s[rt][1][6], s[rt][1][7])};
                pf[rt][3] = (v4u){pk2(s[rt][1][8], s[rt][1][9]), pk2(s[rt][1][10], s[rt][1][11]), pk2(s[rt][1][12], s[rt][1][13]), pk2(s[rt][1][14], s[rt][1][15])};
            }
#pragma unroll
            for (int s4 = 0; s4 < 4; ++s4) {
                const bf16x8 v0 = *(const LAS bf16x8*)(vb + 32 * s4), v1 = *(const LAS bf16x8*)(vb + 32 * KV_STRIDE + 32 * s4);
                o[0][0] = MFMA32(v0, __builtin_bit_cast(bf16x8, pf[0][s4]), o[0][0]); o[0][1] = MFMA32(v1, __builtin_bit_cast(bf16x8, pf[0][s4]), o[0][1]);
                o[1][0] = MFMA32(v0, __builtin_bit_cast(bf16x8, pf[1][s4]), o[1][0]); o[1][1] = MFMA32(v1, __builtin_bit_cast(bf16x8, pf[1][s4]), o[1][1]);
            }
        }
        if (t + 1 < nt) STORE_TILE(buf ^ 1);
        __syncthreads();
    }
#undef TILE_ROW
#undef LOAD_TILE
#undef STORE_TILE
#pragma unroll
    for (int rt = 0; rt < 2; ++rt) {
        const float ltot = pg8::xadd32(l_run[rt]), inv = 1.0f / ltot;
        bf16* op = CAT + (size_t)(qrow0 + qbase + 32 * rt + r32) * DM + head * 64 + 4 * h;
#pragma unroll
        for (int g4 = 0; g4 < 4; ++g4) {
            v2u w0, w1;
            w0.x = pk2(o[rt][0][4 * g4] * inv, o[rt][0][4 * g4 + 1] * inv); w0.y = pk2(o[rt][0][4 * g4 + 2] * inv, o[rt][0][4 * g4 + 3] * inv);
            w1.x = pk2(o[rt][1][4 * g4] * inv, o[rt][1][4 * g4 + 1] * inv); w1.y = pk2(o[rt][1][4 * g4 + 2] * inv, o[rt][1][4 * g4 + 3] * inv);
            *(v2u*)(op + 8 * g4) = w0; *(v2u*)(op + 32 + 8 * g4) = w1;
        }
    }
}

__device__ __forceinline__ void convpool_phase(LAS unsigned char* lds, const bf16* U, bf16* CAT, const float* dw, const float* dwb, const float* lng, const float* lnb, int u0, int ustride, int nunits, int tid, int wave, int lane) {
    LAS float* hbuf = (LAS float*)lds;
    LAS float* cbuf = (LAS float*)(lds + 62 * 256 * 4);
    LAS unsigned char* pbuf = lds + 62 * 256 * 4 + 32 * 256 * 4;
    const int ch = tid & 31, rsub = tid >> 5, c = tid & 255, half = tid >> 8;
    float w[31];
#pragma unroll
    for (int j = 0; j < 31; ++j) w[j] = dw[j * 256 + c];
    const float bias = dwb[c];
    const f32x4 lg = *(const f32x4*)(lng + 4 * lane), lb = *(const f32x4*)(lnb + 4 * lane);
    const int gi = ch >> 3, win = 2 << gi;
    v4u pa[4], pp[3];
#define CP_PREFETCH(cv_) do { const int row0_ = (cv_) * 32; const bool lat_ = row0_ < ML; \
        const int seq0_ = lat_ ? (row0_ & ~(SEQ - 1)) : ML + ((row0_ - ML) & ~(NCTX - 1)); const int send_ = seq0_ + (lat_ ? SEQ : NCTX); \
        _Pragma("unroll") for (int q_ = 0; q_ < 4; ++q_) { const int rr_ = q_ * 16 + rsub; const int grow_ = row0_ - 15 + rr_; pa[q_] = (v4u){0u, 0u, 0u, 0u}; \
            if (rr_ < 62 && grow_ >= seq0_ && grow_ < send_) pa[q_] = *(const v4u*)(U + (size_t)grow_ * INW + 768 + 8 * ch); } \
        _Pragma("unroll") for (int q_ = 0; q_ < 3; ++q_) { const int grow_ = row0_ - 8 + q_ * 16 + rsub; pp[q_] = (v4u){0u, 0u, 0u, 0u}; \
            if (grow_ >= seq0_ && grow_ < send_) pp[q_] = *(const v4u*)(U + (size_t)grow_ * INW + 1280 + 8 * ch); } } while (0)
    if (u0 < nunits) CP_PREFETCH(u0);
    for (int cv = u0; cv < nunits; cv += ustride) {
        const int row0 = cv * 32; const bool latent = row0 < ML;
        const int seq0 = latent ? (row0 & ~(SEQ - 1)) : ML + ((row0 - ML) & ~(NCTX - 1)); const int slen = latent ? SEQ : NCTX;
        __syncthreads();
#pragma unroll
        for (int q = 0; q < 4; ++q) { const int rr = q * 16 + rsub; if (rr < 62) { const v4u a = pa[q];
            *(LAS f32x4*)(hbuf + rr * 256 + 8 * ch) = (f32x4){bflo(a.x), bfhi(a.x), bflo(a.y), bfhi(a.y)}; *(LAS f32x4*)(hbuf + rr * 256 + 8 * ch + 4) = (f32x4){bflo(a.z), bfhi(a.z), bflo(a.w), bfhi(a.w)}; } }
#pragma unroll
        for (int q = 0; q < 3; ++q) *(LAS v4u*)(pbuf + (q * 16 + rsub) * 512 + 16 * ch) = pp[q];
        __syncthreads();
        if (cv + ustride < nunits) CP_PREFETCH(cv + ustride);
        { float hv[46];
#pragma unroll
          for (int i = 0; i < 46; ++i) hv[i] = hbuf[(half * 16 + i) * 256 + c];
          float acc[16];
#pragma unroll
          for (int o = 0; o < 16; ++o) acc[o] = bias;
#pragma unroll
          for (int j = 0; j < 31; ++j) {
#pragma unroll
              for (int o = 0; o < 16; ++o) acc[o] = fmaf(w[j], hv[o + j], acc[o]); }
#pragma unroll
          for (int o = 0; o < 16; ++o) cbuf[(half * 16 + o) * 256 + c] = acc[o]; }
#pragma unroll
        for (int pss = 0; pss < 2; ++pss) { const int pos = pss * 16 + rsub; const int row = row0 + pos; const int t = row - seq0;
            int lo = t - (win >> 1); lo = lo < 0 ? 0 : lo; int hi = t + win - 1 - (win >> 1); hi = hi > slen - 1 ? slen - 1 : hi;
            float s[8];
#pragma unroll
            for (int e = 0; e < 8; ++e) s[e] = 0.f;
            const LAS unsigned char* pb = pbuf + (pos + 8 - (win >> 1)) * 512 + 16 * ch;
#pragma unroll
            for (int k = 0; k < 16; ++k) { if (k < win) { const v4u a = *(const LAS v4u*)(pb + k * 512);
                s[0] += bflo(a.x); s[1] += bfhi(a.x); s[2] += bflo(a.y); s[3] += bfhi(a.y); s[4] += bflo(a.z); s[5] += bfhi(a.z); s[6] += bflo(a.w); s[7] += bfhi(a.w); } }
            const float rc = 1.0f / (float)(hi - lo + 1);
            const v4u x = *(const LAS v4u*)(pbuf + (pos + 8) * 512 + 16 * ch);
            v4u o; o.x = pk2(s[0] * rc - bflo(x.x), s[1] * rc - bfhi(x.x)); o.y = pk2(s[2] * rc - bflo(x.y), s[3] * rc - bfhi(x.y));
            o.z = pk2(s[4] * rc - bflo(x.z), s[5] * rc - bfhi(x.z)); o.w = pk2(s[6] * rc - bflo(x.w), s[7] * rc - bfhi(x.w));
            *(v4u*)(CAT + (size_t)row * DM + 768 + 8 * ch) = o; }
        __syncthreads();
#pragma unroll
        for (int i = 0; i < 4; ++i) { const int r = wave * 4 + i; const f32x4 v = *(const LAS f32x4*)(cbuf + r * 256 + 4 * lane);
            const float mu = wave_sum((v.x + v.y) + (v.z + v.w)) * (1.f / 256.f); const f32x4 d = v - mu;
            const float var = wave_sum((d.x * d.x + d.y * d.y) + (d.z * d.z + d.w * d.w)) * (1.f / 256.f);
            const f32x4 hn = d * rsqrtf(var + EPS) * lg + lb;
            v2u o; o.x = pk2(silu_f(hn.x), silu_f(hn.y)); o.y = pk2(silu_f(hn.z), silu_f(hn.w));
            *(v2u*)(CAT + (size_t)(row0 + r) * DM + 512 + 4 * lane) = o; }
    }
#undef CP_PREFETCH
    __syncthreads();
}

#define RLX_AGENT __ATOMIC_RELAXED, __HIP_MEMORY_SCOPE_AGENT
#define XB_TMO      128
#define XB_XCNT(j)  (256  + 64 * (j))
#define XB_XSUB(j)  (1280 + 64 * (j))
#define XB_XGEN(j)  (2304 + 64 * (j))
#define XB_TOP      3328
#define XB_TOPGEN   3392
#define XCD_BAR_WORDS 3456
#define XB_SPIN_CAP (1u << 18)

__device__ __forceinline__ unsigned xb_ld(unsigned* p)              { return __hip_atomic_load(p, __ATOMIC_RELAXED, __HIP_MEMORY_SCOPE_AGENT); }
__device__ __forceinline__ unsigned xb_add(unsigned* p, unsigned v) { return __hip_atomic_fetch_add(p, v, __ATOMIC_RELAXED, __HIP_MEMORY_SCOPE_AGENT); }
__device__ __forceinline__ unsigned xb_xcc_id() { return (unsigned)__builtin_amdgcn_s_getreg((3 << 11) | 20) & 0xFu; }
#define XB_SPIN(cond, bar) do { unsigned _sp = 0; while (cond) { __builtin_amdgcn_s_sleep(1); \
    if ((++_sp & 255u) == 0u) { if (xb_ld(&(bar)[XB_TMO])) break; if (_sp > XB_SPIN_CAP) { atomicAdd(&(bar)[XB_TMO], 1u); break; } } } } while (0)

struct XcdBarrier {
    unsigned* bar; unsigned x;
    volatile LAS unsigned* st;
};

__device__ __forceinline__ XcdBarrier xcd_barrier_post(unsigned* bar, volatile LAS unsigned* st) {
    XcdBarrier b; b.bar = bar; b.x = xb_xcc_id(); b.st = st;
    if (threadIdx.x == 0) (void)xb_add(&bar[XB_XCNT(b.x)], 1u);
    return b;
}
__device__ __forceinline__ void xcd_barrier_complete(unsigned* bar, unsigned x, unsigned& nloc, unsigned& nx) {
    const unsigned G = gridDim.x * gridDim.y * gridDim.z;
    unsigned sum, cnt, mine, sp = 0u;
    for (;;) {
        sum = 0u; cnt = 0u; mine = 0u;
#pragma unroll
        for (unsigned j = 0; j < 16; ++j) { const unsigned c = xb_ld(&bar[XB_XCNT(j)]); sum += c; cnt += (c > 0u) ? 1u : 0u; mine = (j == x) ? c : mine; }
        if (sum == G) break;
        __builtin_amdgcn_s_sleep(1);
        if ((++sp & 255u) == 0u) { if (xb_ld(&bar[XB_TMO])) break; if (sp > XB_SPIN_CAP) { atomicAdd(&bar[XB_TMO], 1u); break; } }
    }
    nloc = mine > 0u ? mine : 1u; nx = cnt > 0u ? cnt : 1u;
}

__device__ __forceinline__ void xcd_barrier(const XcdBarrier& b) {
    asm volatile("s_waitcnt vmcnt(0)" ::: "memory");
    __syncthreads();
    if (threadIdx.x == 0) {
        unsigned* bar = b.bar;
        __builtin_amdgcn_s_waitcnt(0);
        unsigned nloc = b.st[0], nx = b.st[1];
        if (nloc == 0u) { xcd_barrier_complete(bar, b.x, nloc, nx); b.st[0] = nloc; b.st[1] = nx; }
        const unsigned old = xb_add(&bar[XB_XSUB(b.x)], 1u);
        const unsigned gen = old / nloc;
        if (old + 1u == (gen + 1u) * nloc) {
            __builtin_amdgcn_fence(__ATOMIC_RELEASE, "agent");
            asm volatile("s_waitcnt vmcnt(0)" ::: "memory");
            const unsigned og = xb_add(&bar[XB_TOP], 1u);
            const unsigned tg = og / nx;
            if (og + 1u == (tg + 1u) * nx) xb_add(&bar[XB_TOPGEN], 1u);
            else XB_SPIN(xb_ld(&bar[XB_TOPGEN]) == tg, bar);
            __builtin_amdgcn_fence(__ATOMIC_ACQUIRE, "agent");
            xb_add(&bar[XB_XGEN(b.x)], 1u);
            asm volatile("s_waitcnt vmcnt(0)" ::: "memory");
        } else {
            XB_SPIN(xb_ld(&bar[XB_XGEN(b.x)]) == gen, bar);
            __builtin_amdgcn_fence(__ATOMIC_ACQUIRE, "agent");
            asm volatile("s_waitcnt vmcnt(0)" ::: "memory");
        }
    }
    __syncthreads();
}

__global__ void __launch_bounds__(NWAVES * 64, 2) fwd_megakernel(Params P) {
    extern __shared__ __attribute__((aligned(16))) unsigned char lds_raw[];
    LAS unsigned char* lds = (LAS unsigned char*)lds_raw;
    cg::grid_group grid = cg::this_grid();
    volatile LAS unsigned* MISC = (volatile LAS unsigned*)(lds + RING_BYTES);
    if (threadIdx.x < 64) MISC[threadIdx.x] = 0u;
    __syncthreads();
    if (!MK_SPLIT && blockIdx.x == 0) { unsigned* bw = (unsigned*)(P.ws + WS_CTL); for (int i = threadIdx.x; i < XCD_BAR_WORDS; i += NWAVES * 64) bw[i] = 0u; __threadfence(); }
    XcdBarrier bar; bar.bar = (unsigned*)(P.ws + WS_CTL); bar.x = 0; bar.st = MISC + 8;
    const int G = gridDim.x;
#define FRESH_TID() int tid = threadIdx.x; asm volatile("" : "+v"(tid)); const int lane = tid & 63, wave = __builtin_amdgcn_readfirstlane(tid >> 6); (void)lane; (void)wave
    unsigned char* ws = P.ws;
    float* rope = (float*)(ws + WS_ROPE); float* modb = (float*)(ws + WS_MOD);
    bf16* Amod = (bf16*)(ws + WS_AMOD); bf16* WmodT = (bf16*)(ws + WS_WMODT); bf16* Ash = (bf16*)(ws + WS_ASH); float* bias1 = (float*)(ws + WS_BIAS1); float* bias2 = (float*)(ws + WS_BIAS2); float* SS = (float*)(ws + WS_SS);
    float* XS = (float*)(ws + WS_XS); bf16* H = (bf16*)(ws + WS_H); bf16* U = (bf16*)(ws + WS_U); bf16* CAT = (bf16*)(ws + WS_CAT); bf16* ACT = (bf16*)(ws + WS_ACT);
    const int lo = P.ph_lo, hi = P.ph_hi;
    int ph = 0;
#define IN_PH() (lo <= ph && ph < hi)
#ifndef STG_G2
#define STG_G2 0
#endif
#ifndef STG_G4
#define STG_G4 0
#endif
#define STAGGER(ticks) do { const unsigned grp_ = (blockIdx.x >> 3) & 1u; if ((ticks) > 0 && grp_ && threadIdx.x == 0) { const unsigned long long t0_ = __builtin_amdgcn_s_memrealtime(); \
        while (__builtin_amdgcn_s_memrealtime() - t0_ < (unsigned long long)(ticks) * grp_) __builtin_amdgcn_s_sleep(8); } __syncthreads(); } while (0)
#define SEAM() do { if (!MK_SPLIT) { if (ph == 0) { grid.sync(); bar = xcd_barrier_post((unsigned*)(P.ws + WS_CTL), MISC + 8); } else xcd_barrier(bar); } ++ph; } while (0)

    if (IN_PH()) { FRESH_TID(); phase_p0a(P, lds, G, tid, wave, lane); }
    SEAM();
    if (IN_PH()) {
        if (blockIdx.x < 48) { pg8::Gemm g{Amod, WmodT, 256, 2 * NMOD, DM}; pg8::SchedMod S{(int)blockIdx.x}; pg8::EpiMod E{modb, P.b_mod, Ash};
            pg8::gemm_phase<pg8::EpiMod, pg8::SchedMod, false, true>(lds, g, S, E); }
        else { FRESH_TID(); phase_p0b_convert(P, lds, G, wave, lane); }
    }
    SEAM();
    if (IN_PH()) for (int rep = 0; rep < REP_P0C; ++rep) {
        const int bx = blockIdx.x;
        if (bx < 56) {
            const int l = bx / 28, r = bx % 28, which = r >= 6, pn = which ? r - 6 : r;
            const bf16* Bt = which ? (const bf16*)(ws + WS_WF1T) + (size_t)l * 2 * DFF * DM : (const bf16*)(ws + WS_WINT) + (size_t)l * INW * DM;
            float* outp = which ? bias2 + (size_t)l * 33 * 2 * DFF : bias1 + (size_t)l * 33 * INW;
            pg8::Gemm g{Ash + (size_t)(l * 2 + which) * 256 * 1024, Bt, 256, which ? 2 * DFF : INW, DM}; pg8::SchedOne S{pn, true}; pg8::EpiBias E{outp, which ? 2 * DFF : INW};
            pg8::gemm_phase<pg8::EpiBias, pg8::SchedOne, false, true>(lds, g, S, E);
        }
        { FRESH_TID(); (void)tid;
          constexpr int NQ = MT / 4, QG = 56, WGQ = 56;
          const int nn = G - QG; const int per = (NQ - QG * WGQ + nn - 1) / nn;
          int q0, q1; if (bx < QG) { q0 = bx * WGQ; q1 = q0 + WGQ; } else { q0 = QG * WGQ + (bx - QG) * per; q1 = q0 + per; if (q1 > NQ) q1 = NQ; }
          phase_norm0(P.x, P.ctx, H, SS, P.n1g, modb + 1 * 1024, q0, q1, wave, lane); }
    }
    SEAM();
#pragma unroll 1
    for (int l = 0; l < 2; ++l) {
        const bool last = (l == 1);
        const float* mod_l = modb + l * NMOD;
        const float* srcL = (l == 0) ? P.x : XS; const float* srcC = (l == 0) ? P.ctx : XS + (size_t)ML * DM;
        const int Mff = last ? ML : MT;
        if (IN_PH()) for (int rep = 0; rep < REP_G1; ++rep) { { LAS float* rl = (LAS float*)(lds + ROPE_LDS); for (int i = threadIdx.x; i < 2048; i += 512) rl[i] = rope[i]; __syncthreads(); }
            pg8::Gemm g{H, (const bf16*)(ws + WS_WINT) + (size_t)l * INW * DM, MT, INW, DM}; pg8::StaticOrder S; S.init(MT, INW, G, (int)blockIdx.x); pg8::EpiInProj E{U, (const LAS float*)(lds + ROPE_LDS), SS, bias1 + (size_t)l * 33 * INW};
            pg8::gemm_phase<pg8::EpiInProj, pg8::StaticOrder, true, true>(lds, g, S, E); }
        SEAM();
        if (IN_PH()) for (int rep = 0; rep < REP_MIX; ++rep) {
            FRESH_TID(); const int NA = last ? 1024 : 1152, NCV = last ? (ML / 32) : (MT / 32);
            for (int ra = 0; ra < REP_ATT; ++ra) for (int u = blockIdx.x; u < NA; u += G) attn_unit(lds, U, CAT, P.sink + l * 8, u, tid, wave, lane);
            convpool_phase(lds, U, CAT, P.cdw + l * 31 * 256, P.cdwb + l * 256, P.clng + l * 256, P.clnb + l * 256, (int)blockIdx.x, G, NCV, tid, wave, lane);
        }
        SEAM();
        if (IN_PH()) for (int rep = 0; rep < ((l == 0) ? REP_G2 : 1); ++rep) { STAGGER(STG_G2); pg8::Gemm g{CAT, (const bf16*)(ws + WS_WOUTT) + (size_t)l * DM * DM, Mff, DM, DM}; pg8::StaticOrder S; S.init(Mff, DM, G, (int)blockIdx.x);
            pg8::EpiResid E{srcL, srcC, XS, mod_l + 2 * 1024, H, SS, P.n2g + l * DM, mod_l + 4 * 1024, lds + XPOSE_LDS};
            pg8::gemm_phase<pg8::EpiResid, pg8::StaticOrder, true, true>(lds, g, S, E); }
        SEAM();
        if (IN_PH()) for (int rep = 0; rep < REP_G3; ++rep) { pg8::Gemm g{H, (const bf16*)(ws + WS_WF1T) + (size_t)l * 2 * DFF * DM, Mff, 2 * DFF, DM}; pg8::StaticOrder S; S.init(Mff, 2 * DFF, G, (int)blockIdx.x); pg8::EpiSwiGLU E{ACT, SS, bias2 + (size_t)l * 33 * 2 * DFF, (LAS float*)(lds + XPOSE_LDS)};
            pg8::gemm_phase<pg8::EpiSwiGLU, pg8::StaticOrder, true, true>(lds, g, S, E); }
        SEAM();
        if (IN_PH()) { pg8::Gemm g{ACT, (const bf16*)(ws + WS_WF2T) + (size_t)l * DM * DFF, Mff, DM, DFF}; pg8::StaticOrder S; S.init(Mff, DM, G, (int)blockIdx.x);
            pg8::EpiResid E{XS, XS + (size_t)ML * DM, XS, mod_l + 5 * 1024, last ? (bf16*)nullptr : H, SS, P.n1g + DM, modb + NMOD + 1 * 1024, lds + XPOSE_LDS};
            pg8::gemm_phase<pg8::EpiResid, pg8::StaticOrder, true, true>(lds, g, S, E); }
        SEAM();
    }
    if (IN_PH()) { FRESH_TID(); (void)tid; phase_final(XS, SS, P.out, P.fing, G, wave, lane); }
#undef IN_PH
#undef SEAM
}
constexpr int N_PHASES = 3 + 2 * 5 + 1;

extern "C" void kernel_launch(void* const* d_in, const int* in_sizes, int n_in, void* d_out, int out_size, void* d_ws, size_t ws_size, hipStream_t stream) {
    static int grid = 0;
    if (grid == 0) {
        if (n_in != 20 || ws_size < WS_END) { fprintf(stderr, "kernel_launch: unexpected n_in %d or ws_size %zu (need %zu)\n", n_in, ws_size, (size_t)WS_END); grid = -1; return; }
        int dev = 0, cus = 0, per_cu = 0;
        hipGetDevice(&dev); hipDeviceGetAttribute(&cus, hipDeviceAttributeMultiprocessorCount, dev);
        if (hipFuncSetAttribute((const void*)fwd_megakernel, hipFuncAttributeMaxDynamicSharedMemorySize, LDS_BYTES) != hipSuccess) { fprintf(stderr, "kernel_launch: hipFuncSetAttribute failed\n"); grid = -1; return; }
        if (hipOccupancyMaxActiveBlocksPerMultiprocessor(&per_cu, (const void*)fwd_megakernel, NWAVES * 64, LDS_BYTES) != hipSuccess || per_cu < 1) { fprintf(stderr, "kernel_launch: occupancy query says %d\n", per_cu); per_cu = 1; }
        (void)hipGetLastError();
        grid = cus * per_cu;
        if (grid > 256) grid = 256;
        fprintf(stderr, "kernel_launch: grid %d (cus %d, per_cu %d)\n", grid, cus, per_cu);
    }
    if (grid < 0) return;
    Params p{};
    const float** pp = (const float**)&p;
    for (int i = 0; i < 20; ++i) pp[i] = (const float*)d_in[i];
    p.out = (float*)d_out; p.ws = (unsigned char*)d_ws;
#if MK_SPLIT
    for (int k = 0; k < N_PHASES; ++k) { p.ph_lo = k; p.ph_hi = k + 1; hipLaunchKernelGGL(fwd_megakernel, dim3(grid), dim3(NWAVES * 64), LDS_BYTES, stream, p); }
#else
    p.ph_lo = 0; p.ph_hi = N_PHASES;
    void* args[] = {&p};
    hipError_t e = hipLaunchCooperativeKernel((const void*)fwd_megakernel, dim3(grid), dim3(NWAVES * 64), args, LDS_BYTES, stream);
    if (e != hipSuccess) fprintf(stderr, "kernel_launch: cooperative launch failed: %s (grid %d)\n", hipGetErrorString(e), grid);
#endif
}
```
